# Optimizing an MI355X kernel written in HIP

```python
import jax, jax.numpy as jnp
from jax import lax
import numpy as np

D_MODEL = 2048
BATCH = 4
SEQ = 8192
DEPTH = 4
DEC_BATCH = 16
DEC_SEQ = 32
PAST_LEN = 1024

CHUNK = 64
N_MIXERS = 2
N_HGRN = (DEPTH + 1) // 2
N_ATTN = DEPTH // 2
H_A = 16
DK_A = D_MODEL // H_A
DV_A = D_MODEL // H_A
FORGET_DIM = H_A * DK_A
HGRN_BLOCK = 8
H_B = 16
HD_B = D_MODEL // H_B
N_PREV_CHUNKS = 8
ATTN_WINDOW = N_PREV_CHUNKS * CHUNK
BAND = ATTN_WINDOW + CHUNK
MAX_REL = 256
N_REL = MAX_REL + CHUNK
VAL_LO, VAL_HI = 2 * D_MODEL, 3 * D_MODEL
ALPHA = (2 * DEPTH) ** 0.25
BETA = (8 * DEPTH) ** -0.25
LN_EPS = 1e-5
RMS_EPS = 1e-6
LB_TINY = 1e-30
NEG_BIG = -1e30

kernel_name = "hybrid_hgrn2_chunkband_stream_step"

F32 = jnp.float32


def layer_norm(x, g, b):
    xf = x.astype(F32)
    mu = jnp.mean(xf, axis=-1, keepdims=True)
    var = jnp.mean(jnp.square(xf - mu), axis=-1, keepdims=True)
    return ((xf - mu) * lax.rsqrt(var + LN_EPS) * g.astype(F32) + b.astype(F32)).astype(x.dtype)


def hgrn_lower_bounds(lb_param):
    p = jax.nn.softmax(lb_param.astype(F32), axis=0)
    return jnp.cumsum(p, axis=0) - p[0]


def hgrn_inputs(proj, lb):
    B, T = proj.shape[:2]
    q, z, i, g = jnp.split(proj, [FORGET_DIM, 2 * FORGET_DIM, 2 * FORGET_DIM + D_MODEL], axis=-1)
    zf = z.astype(F32)
    log_lb = jnp.log(jnp.maximum(lb, LB_TINY))
    log_f = jnp.logaddexp(jax.nn.log_sigmoid(zf), log_lb + jax.nn.log_sigmoid(-zf))
    k = (1.0 - lb) * jax.nn.sigmoid(-zf)
    q = jax.nn.silu(q.astype(F32))
    hk = lambda t: t.reshape(B, T, H_A, DK_A)
    return hk(q), hk(k), i.astype(F32).reshape(B, T, H_A, DV_A), hk(log_f), g


def hgrn_prompt(q, k, v, log_f):
    B, S = q.shape[:2]
    nb = S // HGRN_BLOCK
    blk = lambda t: t.reshape(B, nb, HGRN_BLOCK, t.shape[2], t.shape[3])
    q, k, v, log_f = blk(q), blk(k), blk(v), blk(log_f)
    b = jnp.cumsum(log_f, axis=2)
    b_end = b[:, :, -1:]
    causal = jnp.tril(jnp.ones((HGRN_BLOCK, HGRN_BLOCK), dtype=bool))
    diff = b[:, :, :, None] - b[:, :, None, :]
    dec = jnp.exp(jnp.where(causal[:, :, None, None], diff, 0.0))
    a = jnp.einsum('bnthk,bnshk,bntshk->bnhts', q, k, dec)
    a = jnp.where(causal, a, 0.0)
    o_intra = jnp.einsum('bnhts,bnshv->bnthv', a, v)
    qe = q * jnp.exp(b)
    kd = k * jnp.exp(b_end - b)

    def step(state, xs):
        qe_n, kd_n, v_n, dec_n = xs
        o_inter = jnp.einsum('bthk,bhkv->bthv', qe_n, state)
        state = state * dec_n[..., None] + jnp.einsum('bshk,bshv->bhkv', kd_n, v_n)
        return state, o_inter

    s0 = jnp.zeros((B, H_A, DK_A, DV_A), F32)
    xs = (jnp.moveaxis(qe, 1, 0), jnp.moveaxis(kd, 1, 0), jnp.moveaxis(v, 1, 0),
          jnp.moveaxis(jnp.exp(b_end[:, :, 0]), 1, 0))
    s_fin, o_inter = lax.scan(step, s0, xs)
    o = o_intra + jnp.moveaxis(o_inter, 0, 1)
    return o.reshape(B, S, H_A, DV_A), s_fin


def hgrn_sample(q, k, v, log_f, s0):
    def step(state, xs):
        q_t, k_t, v_t, lf_t = xs
        state = state * jnp.exp(lf_t)[..., None] + k_t[..., None] * v_t[..., None, :]
        return state, jnp.einsum('bhk,bhkv->bhv', q_t, state)

    xs = tuple(jnp.moveaxis(t, 1, 0) for t in (q, k, v, log_f))
    s_fin, o = lax.scan(step, s0.astype(F32), xs)
    return jnp.moveaxis(o, 0, 1), s_fin


def hgrn_readout(o, g, norm_g):
    B, T = o.shape[:2]
    o = o * lax.rsqrt(jnp.mean(jnp.square(o), axis=-1, keepdims=True) + RMS_EPS)
    return o.reshape(B, T, D_MODEL) * norm_g.astype(F32) * jax.nn.silu(g.astype(F32))


def attn_inputs(proj):
    B, T = proj.shape[:2]
    q, k, v, g = jnp.split(proj, 4, axis=-1)
    hv = lambda t: t.reshape(B, T, H_B, HD_B)
    return hv(q), hv(k), hv(v), g


def rel_bias(table, n_q, n_k, offset):
    d = offset + jnp.arange(n_q)[:, None] - jnp.arange(n_k)[None, :]
    idx = jnp.clip(d, -(CHUNK - 1), MAX_REL) + (CHUNK - 1)
    return table[:, idx].astype(F32)


def attn_prompt(q, k, v, bias):
    B, S = q.shape[:2]
    n_chunks = S // CHUNK
    pad = ((0, 0), (ATTN_WINDOW, 0), (0, 0), (0, 0))
    kp, vp = jnp.pad(k, pad), jnp.pad(v, pad)
    band_pos = jnp.arange(BAND)
    scale = HD_B ** -0.5

    def one_chunk(c):
        start = c * CHUNK
        qc = lax.dynamic_slice_in_dim(q, start, CHUNK, axis=1)
        kc = lax.dynamic_slice_in_dim(kp, start, BAND, axis=1)
        vc = lax.dynamic_slice_in_dim(vp, start, BAND, axis=1)
        s = jnp.einsum('bqhd,bkhd->bhqk', qc, kc, preferred_element_type=F32) * scale + bias
        valid = (start - ATTN_WINDOW + band_pos) >= 0
        s = jnp.where(valid, s, NEG_BIG)
        p = jax.nn.softmax(s, axis=-1)
        return jnp.einsum('bhqk,bkhd->bqhd', p.astype(vc.dtype), vc)

    o = lax.map(one_chunk, jnp.arange(n_chunks))
    return jnp.moveaxis(o, 0, 1).reshape(B, S, H_B, HD_B)


def attn_sample(q, k_all, v_all, bias):
    s = jnp.einsum('bqhd,bkhd->bhqk', q, k_all, preferred_element_type=F32) * (HD_B ** -0.5) + bias
    p = jax.nn.softmax(s, axis=-1)
    return jnp.einsum('bhqk,bkhd->bqhd', p.astype(v_all.dtype), v_all)


def attn_readout(o, g):
    B, T = o.shape[:2]
    return o.reshape(B, T, D_MODEL).astype(F32) * jax.nn.silu(g.astype(F32))


def setup_inputs(seed: int = 0) -> dict:
    key = jax.random.key(seed)
    ks = jax.random.split(key, 12)
    kv_win = min(ATTN_WINDOW, PAST_LEN)
    x_prompt = jax.random.normal(ks[0], (BATCH, SEQ, D_MODEL), F32)
    x_sample = jax.random.normal(ks[1], (DEC_BATCH, DEC_SEQ, D_MODEL), F32)
    state_hgrn = 0.5 * jax.random.normal(ks[2], (N_HGRN, DEC_BATCH, H_A, DK_A, DV_A), F32)
    cache_attn_k = jax.random.normal(ks[3], (N_ATTN, DEC_BATCH, kv_win, H_B, HD_B), F32)
    cache_attn_v = BETA * jax.random.normal(ks[4], (N_ATTN, DEC_BATCH, kv_win, H_B, HD_B), F32)
    col_scale = jnp.ones((4 * D_MODEL,), F32).at[VAL_LO:VAL_HI].set(BETA)
    w_in = jax.random.normal(ks[5], (DEPTH, D_MODEL, 4 * D_MODEL), F32) * (D_MODEL ** -0.5) * col_scale
    w_out = jax.random.normal(ks[6], (DEPTH, D_MODEL, D_MODEL), F32) * (D_MODEL ** -0.5) * BETA
    ln_g = 1.0 + 0.02 * jax.random.normal(ks[7], (DEPTH, D_MODEL), F32)
    ln_b = 0.02 * jax.random.normal(ks[8], (DEPTH, D_MODEL), F32)
    hgrn_lb = 1.0 + 0.1 * jax.random.normal(ks[9], (N_HGRN, FORGET_DIM), F32)
    hgrn_norm_g = 1.0 + 0.02 * jax.random.normal(ks[10], (N_HGRN, D_MODEL), F32)
    attn_rel_bias = 0.1 * jax.random.normal(ks[11], (N_ATTN, H_B, N_REL), F32)
    return {"x_prompt": x_prompt, "x_sample": x_sample, "state_hgrn": state_hgrn,
            "cache_attn_k": cache_attn_k, "cache_attn_v": cache_attn_v,
            "w_in": w_in, "w_out": w_out, "ln_g": ln_g, "ln_b": ln_b,
            "hgrn_lb": hgrn_lb, "hgrn_norm_g": hgrn_norm_g, "attn_rel_bias": attn_rel_bias}


def reference(x_prompt, x_sample, state_hgrn, cache_attn_k, cache_attn_v,
              w_in, w_out, ln_g, ln_b, hgrn_lb, hgrn_norm_g, attn_rel_bias):
    lbs = hgrn_lower_bounds(hgrn_lb)
    kv_win = cache_attn_k.shape[2]
    dec_seq = x_sample.shape[1]
    prompt_win = min(ATTN_WINDOW, x_prompt.shape[1])
    hp, hs = x_prompt, x_sample
    st_p, st_s, kp_rows, vp_rows, ks_rows, vs_rows = [], [], [], [], [], []
    for layer in range(DEPTH):
        j = layer // N_MIXERS
        proj_p = hp @ w_in[layer]
        proj_s = hs @ w_in[layer]
        if layer % N_MIXERS == 0:
            q, k, v, lf, g = hgrn_inputs(proj_p, lbs[j])
            o, s_fin = hgrn_prompt(q, k, v, lf)
            mix_p = hgrn_readout(o, g, hgrn_norm_g[j])
            q, k, v, lf, g = hgrn_inputs(proj_s, lbs[j])
            o, s_new = hgrn_sample(q, k, v, lf, state_hgrn[j])
            mix_s = hgrn_readout(o, g, hgrn_norm_g[j])
            st_p.append(s_fin.astype(state_hgrn.dtype))
            st_s.append(s_new.astype(state_hgrn.dtype))
        else:
            table = attn_rel_bias[j]
            q, k, v, g = attn_inputs(proj_p)
            o = attn_prompt(q, k, v, rel_bias(table, CHUNK, BAND, ATTN_WINDOW))
            mix_p = attn_readout(o, g)
            kp_rows.append(k[:, -prompt_win:])
            vp_rows.append(v[:, -prompt_win:])
            q, k, v, g = attn_inputs(proj_s)
            k_all = jnp.concatenate([cache_attn_k[j].astype(k.dtype), k], axis=1)
            v_all = jnp.concatenate([cache_attn_v[j].astype(v.dtype), v], axis=1)
            o = attn_sample(q, k_all, v_all, rel_bias(table, dec_seq, kv_win + dec_seq, kv_win))
            mix_s = attn_readout(o, g)
            ks_rows.append(k)
            vs_rows.append(v)
        hp = layer_norm(ALPHA * hp + mix_p.astype(hp.dtype) @ w_out[layer], ln_g[layer], ln_b[layer])
        hs = layer_norm(ALPHA * hs + mix_s.astype(hs.dtype) @ w_out[layer], ln_g[layer], ln_b[layer])
    state_hgrn_prompt = jnp.stack(st_p)
    state_hgrn_sample = jnp.stack(st_s)
    cache_k_prompt = jnp.stack(kp_rows)
    cache_v_prompt = jnp.stack(vp_rows)
    cache_k_sample = jnp.stack(ks_rows)
    cache_v_sample = jnp.stack(vs_rows)
    return (hp, hs, state_hgrn_prompt, state_hgrn_sample,
            cache_k_prompt, cache_v_prompt, cache_k_sample, cache_v_sample)
```

```cpp
#include <hip/hip_runtime.h>
#include <hip/hip_cooperative_groups.h>
#include <cstdio>
#include <cstdint>
namespace cg = cooperative_groups;

constexpr int DM = 2048, MPR = 32768, MSM = 512, MT = MPR + MSM, N4 = 8192;
constexpr float ALPHA_RES = 1.681792830507429f;
constexpr float ATT_SCALE = 0.08838834764831845f;
constexpr size_t O_YP = 0, O_YS = 67108864, O_STP = 68157440, O_STS = 70254592, O_CKP = 78643200, O_CVP = 87031808, O_CKS = 95420416, O_CVS = 97517568;
constexpr size_t WS_WIN = 0, WS_WOUT = 134217728, WS_HB = 167772160, WS_PROJ = 304087040, WS_MIX = 849346560, WS_DBUF = 985661440, WS_SCR = 989986816, WS_USEG = 1002569728, WS_DSEG = 1019346944, WS_CTL = 1019478016, WS_END = 1019494400;
constexpr int LDS_BYTES = 135168;

namespace pg8 {
#define PG8_LAS __attribute__((address_space(3)))
typedef unsigned short bf16_t;
typedef short bf16x8 __attribute__((ext_vector_type(8)));
typedef float f32x4 __attribute__((ext_vector_type(4)));
typedef unsigned u32x4 __attribute__((ext_vector_type(4)));
constexpr int BM = 256, BK = 64, HALF = 128, HTB = HALF * BK * 2  , STAGE_BYTES = 8 * HTB, NXCD = 8, WGM = 4;

__host__ __device__ __forceinline__ int lds_byte(int r, int c) { const int st = (r >> 4) * 2 + (c >> 5), rr = r & 15, cc = c & 31, ob = rr * 64 + cc * 2; return st * 1024 + (ob ^ (((ob >> 9) & 1) << 5)); }
__host__ __device__ __forceinline__ void stage_rc(int b, int& R, int& C) { const int st = b / 1024, sb = b % 1024, swz = sb ^ (((sb >> 9) & 1) << 5); R = (st >> 1) * 16 + swz / 64; C = (st & 1) * 32 + (swz % 64) / 2; }
__host__ __device__ __forceinline__ int perm32(int rho) { const int n = rho >> 4, i = rho & 15; return 8 * (i >> 2) + 4 * n + (i & 3); }

struct Unit { int pm, pn; };
struct Gemm { const bf16_t* A; const bf16_t* Bt; int M, N, K; };

struct StaticOrder {
    int nM, nN, nwg, G, c;
    __host__ __device__ void init(int M, int N, int G_, int c_) { nM = M / BM; nN = N / BM; nwg = nM * nN; G = G_; c = c_; }
    __host__ __device__ bool next(int i, Unit& u) const {
        const long L = (long)i * G + c; if (L >= nwg) return false;
        int wgid = (int)L; { const int q = nwg / NXCD, r = nwg % NXCD, xcd = wgid % NXCD, off = wgid / NXCD; wgid = (xcd < r ? xcd * (q + 1) : r * (q + 1) + (xcd - r) * q) + off; }
        const int nig = WGM * nN, gid = wgid / nig, fm = gid * WGM, gsz = (nM - fm) < WGM ? (nM - fm) : WGM;
        u.pm = fm + ((wgid % nig) % gsz); u.pn = (wgid % nig) / gsz; return true;
    }
    __device__ __forceinline__ void a_ready(const Unit&) const {}
    __device__ __forceinline__ void done(const Unit&) const {}
};
template <class Epi, class Sched, bool ALIGN_EPI = false, bool SP2 = false>
__device__ __forceinline__ void gemm_phase(PG8_LAS unsigned char* lds, const Gemm g, const Sched& S, const Epi& E, const int tid) {
    const int wid = __builtin_amdgcn_readfirstlane(tid >> 6), lane = tid & 63, wr = wid >> 2, wc = wid & 3, fr = lane & 15, fq = lane >> 4;
    const int K = g.K, nt = K / BK;
    unsigned voffA[2], voffB[2];
#pragma unroll
    for (int i = 0; i < 2; ++i) { int R, C; stage_rc(tid * 16 + i * 8192, R, C); const int Rb = Epi::PERM ? ((R & ~31) + perm32(R & 31)) : R;
        voffA[i] = (unsigned)(R * K + C) * 2u; voffB[i] = (unsigned)(Rb * K + C) * 2u; }
    const size_t kstep = (size_t)(BK * 2);
    const size_t hstep = (size_t)HALF * K * 2;
    const size_t tstep = 2 * hstep;
    const unsigned ldsw = (unsigned)wid * 1024u;
    const int aoff = lds_byte(wr * 64 + fr, fq * 8), boff = lds_byte(wc * 32 + fr, fq * 8);
#define PG8_SA(b, h) (((b) * 2 + (h)) * HTB)
#define PG8_SB(b, h) ((4 + (b) * 2 + (h)) * HTB)
#define PG8_STAGE(bufoff, gbase, voff) do { _Pragma("unroll") for (int _i = 0; _i < 2; ++_i) \
        __builtin_amdgcn_global_load_lds((const unsigned*)((const char*)(gbase) + (voff)[_i]), (PG8_LAS unsigned*)(lds + (bufoff) + ldsw + _i * 8192), 16, 0, 0); } while (0)
#define PG8_LDA(dst, b, h) do { _Pragma("unroll") for (int m = 0; m < 4; ++m) _Pragma("unroll") for (int k = 0; k < 2; ++k) dst[m][k] = *(const PG8_LAS bf16x8*)(lds + PG8_SA(b, h) + aoff + m * 2048 + k * 1024); } while (0)
#define PG8_LDB(dst, b, h) do { _Pragma("unroll") for (int n = 0; n < 2; ++n) _Pragma("unroll") for (int k = 0; k < 2; ++k) dst[n][k] = *(const PG8_LAS bf16x8*)(lds + PG8_SB(b, h) + boff + n * 2048 + k * 1024); } while (0)
#define PG8_MMA(ai, bj, At, Bt) do { __builtin_amdgcn_s_setprio(1); _Pragma("unroll") for (int m = 0; m < 4; ++m) _Pragma("unroll") for (int n = 0; n < 2; ++n) _Pragma("unroll") for (int k = 0; k < 2; ++k) \
        acc[ai][bj][m][n] = __builtin_amdgcn_mfma_f32_16x16x32_bf16(Bt[n][k], At[m][k], acc[ai][bj][m][n], 0, 0, 0); __builtin_amdgcn_s_setprio(0); } while (0)
#define PG8_WAIT_V(n) asm volatile("s_waitcnt vmcnt(" #n ")" ::: "memory")
#define PG8_WAIT_L(n) asm volatile("s_waitcnt lgkmcnt(" #n ")" ::: "memory")
#define PG8_BAR __builtin_amdgcn_s_barrier()
#define PG8_SCHED __builtin_amdgcn_sched_barrier(0)
    Unit cur, nxt; int ui = 0;
    if (!S.next(0, cur)) return;
    f32x4 acc[2][2][4][2];
#pragma unroll
    for (int a = 0; a < 2; ++a)
#pragma unroll
        for (int b = 0; b < 2; ++b)
#pragma unroll
            for (int m = 0; m < 4; ++m)
#pragma unroll
                for (int n = 0; n < 2; ++n) acc[a][b][m][n] = (f32x4){0.f, 0.f, 0.f, 0.f};
    bf16x8 At[4][2], B0[2][2], B1[2][2];
    const char* cA = (const char*)g.A + (size_t)cur.pm * tstep; const char* cB = (const char*)g.Bt + (size_t)cur.pn * tstep;
    S.a_ready(cur);
    if constexpr (SP2) {
        PG8_STAGE(PG8_SB(0, 0), cB, voffB); PG8_STAGE(PG8_SB(0, 1), cB + hstep, voffB); PG8_STAGE(PG8_SA(0, 0), cA, voffA); PG8_STAGE(PG8_SA(0, 1), cA + hstep, voffA);
        if (wr == 1) PG8_BAR;
        PG8_WAIT_V(2); PG8_BAR;
        PG8_STAGE(PG8_SB(1, 0), cB + kstep, voffB); PG8_STAGE(PG8_SA(1, 0), cA + kstep, voffA); PG8_STAGE(PG8_SB(1, 1), cB + hstep + kstep, voffB);
        PG8_WAIT_V(6); PG8_BAR;
    } else {
        PG8_STAGE(PG8_SB(0, 0), cB, voffB); PG8_STAGE(PG8_SA(0, 0), cA, voffA); PG8_STAGE(PG8_SB(0, 1), cB + hstep, voffB); PG8_STAGE(PG8_SA(0, 1), cA + hstep, voffA);
        if (wr == 1) PG8_BAR;
        PG8_WAIT_V(4); PG8_BAR;
        PG8_STAGE(PG8_SB(1, 0), cB + kstep, voffB); PG8_STAGE(PG8_SA(1, 0), cA + kstep, voffA); PG8_STAGE(PG8_SB(1, 1), cB + hstep + kstep, voffB);
        PG8_WAIT_V(6); PG8_BAR;
    }
    for (;;) {
        const bool has_next = S.next(ui + 1, nxt);
        const char* nA = has_next ? (const char*)g.A + (size_t)nxt.pm * tstep : cA; const char* nB = has_next ? (const char*)g.Bt + (size_t)nxt.pn * tstep : cB;
        for (int t = 0; t < nt; t += 2) {
            const bool last = (t == nt - 2);
            const char* a1 = cA + (size_t)(t + 1) * kstep;
            const char* a2 = last ? nA : cA + (size_t)(t + 2) * kstep; const char* b2 = last ? nB : cB + (size_t)(t + 2) * kstep;
            const char* a3 = a2 + kstep; const char* b3 = b2 + kstep;
            if (last && has_next) S.a_ready(nxt);
            if constexpr (SP2) {
            PG8_LDB(B0, 0, 0); PG8_LDB(B1, 0, 1); PG8_SCHED; PG8_LDA(At, 0, 0); PG8_STAGE(PG8_SA(1, 1), a1 + hstep, voffA);
            PG8_WAIT_V(8); PG8_WAIT_L(0); PG8_BAR; PG8_MMA(0, 0, At, B0); PG8_MMA(0, 1, At, B1); PG8_BAR; PG8_SCHED;
            PG8_LDA(At, 0, 1); PG8_STAGE(PG8_SB(0, 0), b2, voffB); PG8_STAGE(PG8_SB(0, 1), b2 + hstep, voffB); PG8_STAGE(PG8_SA(0, 0), a2, voffA);
            PG8_WAIT_V(8); PG8_WAIT_L(0); PG8_BAR; PG8_MMA(1, 0, At, B0); PG8_MMA(1, 1, At, B1); PG8_BAR; PG8_SCHED;
            PG8_LDB(B0, 1, 0); PG8_LDB(B1, 1, 1); PG8_SCHED; PG8_LDA(At, 1, 0); PG8_STAGE(PG8_SA(0, 1), a2 + hstep, voffA);
            PG8_WAIT_V(8); PG8_WAIT_L(0); PG8_BAR; PG8_MMA(0, 0, At, B0); PG8_MMA(0, 1, At, B1); PG8_BAR; PG8_SCHED;
            PG8_LDA(At, 1, 1); PG8_STAGE(PG8_SB(1, 0), b3, voffB); PG8_STAGE(PG8_SB(1, 1), b3 + hstep, voffB); PG8_STAGE(PG8_SA(1, 0), a3, voffA);
            PG8_WAIT_V(8); PG8_WAIT_L(0); PG8_BAR; PG8_MMA(1, 0, At, B0); PG8_MMA(1, 1, At, B1); PG8_BAR; PG8_SCHED;
            } else {
            PG8_LDB(B0, 0, 0); PG8_SCHED; PG8_LDA(At, 0, 0); PG8_STAGE(PG8_SA(1, 1), a1 + hstep, voffA);
            PG8_WAIT_L(8); PG8_BAR; PG8_WAIT_L(0); PG8_MMA(0, 0, At, B0); PG8_BAR; PG8_SCHED;
            PG8_LDB(B1, 0, 1); PG8_STAGE(PG8_SB(0, 0), b2, voffB);
            PG8_BAR; PG8_WAIT_L(0); PG8_MMA(0, 1, At, B1); PG8_BAR;
            PG8_LDA(At, 0, 1); PG8_STAGE(PG8_SA(0, 0), a2, voffA);
            PG8_BAR; PG8_WAIT_L(0); PG8_MMA(1, 0, At, B0); PG8_BAR; PG8_SCHED;
            PG8_STAGE(PG8_SB(0, 1), b2 + hstep, voffB);
            PG8_WAIT_V(6); PG8_BAR; PG8_MMA(1, 1, At, B1); PG8_BAR;
            PG8_LDB(B0, 1, 0); PG8_SCHED; PG8_LDA(At, 1, 0); PG8_STAGE(PG8_SA(0, 1), a2 + hstep, voffA);
            PG8_WAIT_L(8); PG8_BAR; PG8_WAIT_L(0); PG8_MMA(0, 0, At, B0); PG8_BAR; PG8_SCHED;
            PG8_LDB(B1, 1, 1); PG8_STAGE(PG8_SB(1, 0), b3, voffB);
            PG8_BAR; PG8_WAIT_L(0); PG8_MMA(0, 1, At, B1); PG8_BAR;
            PG8_LDA(At, 1, 1); PG8_STAGE(PG8_SA(1, 0), a3, voffA);
            PG8_BAR; PG8_WAIT_L(0); PG8_MMA(1, 0, At, B0); PG8_BAR; PG8_SCHED;
            PG8_STAGE(PG8_SB(1, 1), b3 + hstep, voffB);
            PG8_WAIT_V(6); PG8_BAR; PG8_MMA(1, 1, At, B1); PG8_BAR;
            }
        }
        if constexpr (ALIGN_EPI) { if (wr == 0) PG8_BAR; }
        if constexpr (!Epi::AFTER_DRAIN) { E(acc, cur, wr, wc, fr, fq); S.done(cur); }
        if (!has_next) break;
#pragma unroll
        for (int a = 0; a < 2; ++a)
#pragma unroll
            for (int b = 0; b < 2; ++b)
#pragma unroll
                for (int m = 0; m < 4; ++m)
#pragma unroll
                    for (int n = 0; n < 2; ++n) acc[a][b][m][n] = (f32x4){0.f, 0.f, 0.f, 0.f};
        cur = nxt; cA = nA; cB = nB; ++ui;
        if constexpr (ALIGN_EPI) { if (wr == 1) PG8_BAR; }
    }
    PG8_WAIT_V(0);
    if constexpr (!ALIGN_EPI) { if (wr == 0) PG8_BAR; }
    PG8_BAR;
    if constexpr (Epi::AFTER_DRAIN) { E.fused(acc, cur, wr, wc, fr, fq, lds, wid, lane); S.done(cur); }
#undef PG8_SA
#undef PG8_SB
#undef PG8_STAGE
#undef PG8_LDA
#undef PG8_LDB
#undef PG8_MMA
#undef PG8_WAIT_V
#undef PG8_WAIT_L
#undef PG8_BAR
#undef PG8_SCHED
}
}
using pg8::bf16_t; using pg8::bf16x8; using pg8::f32x4; using pg8::u32x4;
typedef short bf16x4 __attribute__((ext_vector_type(4)));
typedef unsigned u32x2 __attribute__((ext_vector_type(2)));
typedef __bf16 hbf2 __attribute__((ext_vector_type(2)));
typedef float f32x2 __attribute__((ext_vector_type(2)));
#define LAS __attribute__((address_space(3)))
#define MFMA16(a, b, c) __builtin_amdgcn_mfma_f32_16x16x32_bf16((a), (b), (c), 0, 0, 0)

__device__ __forceinline__ unsigned pk2(float lo, float hi) { f32x2 v = {lo, hi}; hbf2 b = __builtin_convertvector(v, hbf2); return __builtin_bit_cast(unsigned, b); }
__device__ __forceinline__ bf16_t f2bf(float f) { return (bf16_t)(pk2(f, 0.f) & 0xffffu); }
__device__ __forceinline__ float bf2f(short b) { return __uint_as_float(((unsigned)(unsigned short)b) << 16); }
__device__ __forceinline__ bf16x8 pack8(f32x4 a, f32x4 b) { u32x4 w = {pk2(a[0], a[1]), pk2(a[2], a[3]), pk2(b[0], b[1]), pk2(b[2], b[3])}; return __builtin_bit_cast(bf16x8, w); }
__device__ __forceinline__ u32x2 pack4(f32x4 a) { u32x2 w = {pk2(a[0], a[1]), pk2(a[2], a[3])}; return w; }
__device__ __forceinline__ bf16x8 cat8(bf16x4 lo, bf16x4 hi) { return __builtin_shufflevector(lo, hi, 0, 1, 2, 3, 4, 5, 6, 7); }
__device__ __forceinline__ float fexp(float x) { return __builtin_amdgcn_exp2f(x * 1.4426950408889634f); }
__device__ __forceinline__ float flog(float x) { return __builtin_amdgcn_logf(x) * 0.6931471805599453f; }
__device__ __forceinline__ float silu_f(float x) { return x * __builtin_amdgcn_rcpf(1.f + fexp(-x)); }
__device__ __forceinline__ float wave_sum(float v) {
#pragma unroll
    for (int o = 1; o < 64; o <<= 1) v += __shfl_xor(v, o);
    return v;
}

struct Params {
    const float* xp; const float* xs; const float* st_in; const float* ck_in; const float* cv_in;
    const float* w_in; const float* w_out; const float* ln_g; const float* ln_b; const float* lb; const float* ng; const float* rb;
    float* out; unsigned char* ws;
};

namespace pg8 {
template <bool NT> struct EpiProjT {
    static constexpr bool PERM = true, AFTER_DRAIN = false;
    bf16_t* O; int ldc;
    __device__ __forceinline__ void operator()(const f32x4 (&acc)[2][2][4][2], const Unit& u, int wr, int wc, int fr, int fq) const {
        const int row0 = u.pm * BM + wr * 64 + fr, col0 = u.pn * BM + wc * 32 + 8 * fq;
#pragma unroll
        for (int ai = 0; ai < 2; ++ai)
#pragma unroll
            for (int m = 0; m < 4; ++m) { bf16_t* rowp = O + (size_t)(row0 + ai * HALF + m * 16) * ldc + col0;
#pragma unroll
                for (int bj = 0; bj < 2; ++bj) { const f32x4 v0 = acc[ai][bj][m][0], v1 = acc[ai][bj][m][1];
                    u32x4 w; w.x = pk2(v0[0], v0[1]); w.y = pk2(v0[2], v0[3]); w.z = pk2(v1[0], v1[1]); w.w = pk2(v1[2], v1[3]);
                    if constexpr (NT) __builtin_nontemporal_store(w, (u32x4*)(rowp + bj * HALF)); else *(u32x4*)(rowp + bj * HALF) = w; } }
    }
};
struct EpiRes {
    static constexpr bool PERM = false, AFTER_DRAIN = false;
    const float* xp; const float* xs; float* hf; int layer;
    __device__ __forceinline__ void operator()(const f32x4 (&acc)[2][2][4][2], const Unit& u, int wr, int wc, int fr, int fq) const {
        const int row0 = u.pm * BM + wr * 64 + fr, col0 = u.pn * BM + wc * 32 + 4 * fq;
#pragma unroll
        for (int ai = 0; ai < 2; ++ai)
#pragma unroll
            for (int m = 0; m < 4; ++m) { const int row = row0 + ai * HALF + m * 16;
                const float* res = (layer == 0) ? (row < MPR ? xp + (size_t)row * DM : xs + (size_t)(row - MPR) * DM) : hf + (size_t)row * DM;
                float* outp = hf + (size_t)row * DM;
#pragma unroll
                for (int bj = 0; bj < 2; ++bj)
#pragma unroll
                    for (int n = 0; n < 2; ++n) { const int c = col0 + bj * HALF + n * 16; const f32x4 r = *(const f32x4*)(res + c);
                        *(f32x4*)(outp + c) = r * ALPHA_RES + acc[ai][bj][m][n]; } }
    }
};
}
namespace pg8 {
__device__ __forceinline__ void mini_gemm(PG8_LAS unsigned char* lds, const bf16_t* A, const bf16_t* Bt, bf16_t* O, int ldc, int N, int blk, int G, const int tid) {
    const int wid = __builtin_amdgcn_readfirstlane(tid >> 6), lane = tid & 63, wr = wid >> 2, wc = wid & 3, fr = lane & 15, fq = lane >> 4;
    constexpr int K = 2048, NKT = K / BK;
    unsigned voffA[2], voffB[2];
#pragma unroll
    for (int i = 0; i < 2; ++i) { int R, C; stage_rc(tid * 16 + i * 8192, R, C); const int Rb = (R & ~31) + perm32(R & 31);
        voffA[i] = (unsigned)(R * K + C) * 2u; voffB[i] = (unsigned)(Rb * K + C) * 2u; }
    const unsigned ldsw = (unsigned)wid * 1024u;
    const int aoff = lds_byte(wr * 64 + fr, fq * 8), boff = lds_byte(wc * 32 + fr, fq * 8);
#define MG_STAGE(s, kt) do { _Pragma("unroll") for (int _i = 0; _i < 2; ++_i) { \
        __builtin_amdgcn_global_load_lds((const unsigned*)(cA + (size_t)(kt) * (BK * 2) + voffA[_i]), (PG8_LAS unsigned*)(lds + (s) * 32768 + ldsw + _i * 8192), 16, 0, 0); \
        __builtin_amdgcn_global_load_lds((const unsigned*)(cB + (size_t)(kt) * (BK * 2) + voffB[_i]), (PG8_LAS unsigned*)(lds + (s) * 32768 + 16384 + ldsw + _i * 8192), 16, 0, 0); } } while (0)
#define MG_COMPUTE(s) do { bf16x8 At[4][2], Bf[2][2]; \
        _Pragma("unroll") for (int n = 0; n < 2; ++n) _Pragma("unroll") for (int k = 0; k < 2; ++k) Bf[n][k] = *(const PG8_LAS bf16x8*)(lds + (s) * 32768 + 16384 + boff + n * 2048 + k * 1024); \
        _Pragma("unroll") for (int m = 0; m < 4; ++m) _Pragma("unroll") for (int k = 0; k < 2; ++k) At[m][k] = *(const PG8_LAS bf16x8*)(lds + (s) * 32768 + aoff + m * 2048 + k * 1024); \
        asm volatile("s_waitcnt lgkmcnt(0)" ::: "memory"); __builtin_amdgcn_sched_barrier(0); \
        _Pragma("unroll") for (int m = 0; m < 4; ++m) _Pragma("unroll") for (int n = 0; n < 2; ++n) _Pragma("unroll") for (int k = 0; k < 2; ++k) \
            acc[m][n] = __builtin_amdgcn_mfma_f32_16x16x32_bf16(Bf[n][k], At[m][k], acc[m][n], 0, 0, 0); \
        __builtin_amdgcn_sched_barrier(0); } while (0)
    const int nunits = 4 * (N / 128);
    for (int u = blk; u < nunits; u += G) {
        const int tm = u & 3, tn = u >> 2;
        const char* cA = (const char*)(A + (size_t)tm * 128 * K); const char* cB = (const char*)(Bt + (size_t)tn * 128 * K);
        f32x4 acc[4][2];
#pragma unroll
        for (int m = 0; m < 4; ++m)
#pragma unroll
            for (int n = 0; n < 2; ++n) acc[m][n] = (f32x4){0.f, 0.f, 0.f, 0.f};
        MG_STAGE(0, 0); MG_STAGE(1, 1); MG_STAGE(2, 2);
        for (int kt = 0; kt < NKT - 3; ++kt) {
            asm volatile("s_waitcnt vmcnt(8)" ::: "memory"); __builtin_amdgcn_s_barrier(); __builtin_amdgcn_sched_barrier(0);
            MG_STAGE((kt + 3) & 3, kt + 3);
            MG_COMPUTE(kt & 3);
        }
        asm volatile("s_waitcnt vmcnt(8)" ::: "memory"); __builtin_amdgcn_s_barrier(); __builtin_amdgcn_sched_barrier(0); MG_COMPUTE((NKT - 3) & 3);
        asm volatile("s_waitcnt vmcnt(4)" ::: "memory"); __builtin_amdgcn_s_barrier(); __builtin_amdgcn_sched_barrier(0); MG_COMPUTE((NKT - 2) & 3);
        asm volatile("s_waitcnt vmcnt(0)" ::: "memory"); __builtin_amdgcn_s_barrier(); __builtin_amdgcn_sched_barrier(0); MG_COMPUTE((NKT - 1) & 3);
        const int row0 = tm * 128 + wr * 64 + fr, col0 = tn * 128 + wc * 32 + 8 * fq;
#pragma unroll
        for (int m = 0; m < 4; ++m) { const f32x4 v0 = acc[m][0], v1 = acc[m][1]; u32x4 w; w.x = pk2(v0[0], v0[1]); w.y = pk2(v0[2], v0[3]); w.z = pk2(v1[0], v1[1]); w.w = pk2(v1[2], v1[3]);
            *(u32x4*)(O + (size_t)(row0 + m * 16) * ldc + col0) = w; }
        __builtin_amdgcn_s_barrier();
    }
    asm volatile("s_waitcnt vmcnt(0)" ::: "memory");
#undef MG_STAGE
#undef MG_COMPUTE
}
}

template <bool ntst> __device__ __forceinline__ void p0_transpose_item(const float* W, int K, int N, bf16_t* WT, LAS float* scr, int item, int lane) {
    const int nblk = N / 32, kb = item / nblk, nb = item % nblk, k0 = 64 * kb, n0 = 32 * nb;
    float r[32];
#pragma unroll
    for (int i = 0; i < 32; ++i) { const int kk = 2 * i + (lane >> 5); r[i] = __builtin_nontemporal_load(W + (size_t)(k0 + kk) * N + n0 + (lane & 31)); }
#pragma unroll
    for (int i = 0; i < 32; ++i) { const int kk = 2 * i + (lane >> 5); scr[kk * 33 + (lane & 31)] = r[i]; }
    asm volatile("s_waitcnt lgkmcnt(0)" ::: "memory");
    const int c = lane & 7;
#pragma unroll
    for (int j = 0; j < 4; ++j) { const int n = (lane >> 3) + 8 * j; const LAS float* s = scr + (8 * c) * 33 + n;
        u32x4 o; o.x = pk2(s[0 * 33], s[1 * 33]); o.y = pk2(s[2 * 33], s[3 * 33]); o.z = pk2(s[4 * 33], s[5 * 33]); o.w = pk2(s[6 * 33], s[7 * 33]);
        if (ntst) __builtin_nontemporal_store(o, (u32x4*)(WT + (size_t)(n0 + n) * K + k0 + 8 * c)); else *(u32x4*)(WT + (size_t)(n0 + n) * K + k0 + 8 * c) = o; }
    asm volatile("s_waitcnt lgkmcnt(0)" ::: "memory");
}
__device__ __forceinline__ void p0_phase(unsigned char* lds, const Params& p, bf16_t* win_t, bf16_t* wout_t, bf16_t* hb, int blk, int G, int tid) {
    const int lane = tid & 63, wave = tid >> 6;
    { const size_t ngrp = (size_t)MT * DM / 8, npg = (size_t)MPR * DM / 8, stride = (size_t)G * 512;
      for (size_t i0 = (size_t)blk * 512 + tid; i0 < ngrp; i0 += 4 * stride) {
          f32x4 a[4], b[4];
#pragma unroll
          for (int q = 0; q < 4; ++q) { const size_t i = i0 + q * stride; if (i < ngrp) { const float* s = (i < npg) ? p.xp + i * 8 : p.xs + (i - npg) * 8; a[q] = __builtin_nontemporal_load((const f32x4*)s); b[q] = __builtin_nontemporal_load((const f32x4*)(s + 4)); } }
#pragma unroll
          for (int q = 0; q < 4; ++q) { const size_t i = i0 + q * stride; if (i < ngrp) *(bf16x8*)(hb + i * 8) = pack8(a[q], b[q]); }
      } }
    LAS float* scr = (LAS float*)((LAS unsigned char*)lds + wave * 16384);
    const int gw = blk * 8 + wave, NGW = G * 8;
    for (int it = gw; it < 40960; it += NGW) {
        if (it < 8192) { p0_transpose_item<false>(p.w_in, DM, N4, win_t, scr, it, lane); }
        else if (it < 32768) { const int l = it >> 13, r = it & 8191; p0_transpose_item<true>(p.w_in + (size_t)l * DM * N4, DM, N4, win_t + (size_t)l * N4 * DM, scr, r, lane); }
        else { const int i2 = it - 32768, l = i2 >> 11, r = i2 & 2047; p0_transpose_item<true>(p.w_out + (size_t)l * DM * DM, DM, DM, wout_t + (size_t)l * DM * DM, scr, r, lane); }
    }
}

__device__ __forceinline__ void ln_phase(const Params& p, int layer, float* hf, bf16_t* hb, const bf16_t* yb, const float* g, const float* b, int blk, int G, int tid) {
    const int lane = tid & 63, wave = tid >> 6;
    f32x4 v[8]; u32x2 y[8];
#define UNPK4(D, W) do { D[0] = __uint_as_float((W)[0] << 16); D[1] = __uint_as_float((W)[0] & 0xffff0000u); D[2] = __uint_as_float((W)[1] << 16); D[3] = __uint_as_float((W)[1] & 0xffff0000u); } while (0)
#define LN_LOAD(V, Y, m_) do { const int mm_ = (m_); const bf16_t* yr_ = yb + (size_t)mm_ * DM + lane * 4; \
        if (layer == 0) { const float* res_ = (mm_ < MPR ? p.xp + (size_t)mm_ * DM : p.xs + (size_t)(mm_ - MPR) * DM) + lane * 4; \
            _Pragma("unroll") for (int j = 0; j < 8; ++j) V[j] = __builtin_nontemporal_load((const f32x4*)(res_ + j * 256)); } \
        else { const bf16_t* res_ = hb + (size_t)mm_ * DM + lane * 4; \
            _Pragma("unroll") for (int j = 0; j < 8; ++j) { const u32x2 w_ = __builtin_nontemporal_load((const u32x2*)(res_ + j * 256)); UNPK4(V[j], w_); } } \
        _Pragma("unroll") for (int j = 0; j < 8; ++j) Y[j] = __builtin_nontemporal_load((const u32x2*)(yr_ + j * 256)); } while (0)
    int m = blk * 8 + wave;
    if (m < MT) LN_LOAD(v, y, m);
    while (m < MT) {
        const int mn = m + G * 8;
        f32x4 v2[8]; u32x2 y2[8];
#pragma unroll
        for (int j = 0; j < 8; ++j) { v2[j] = (f32x4){0.f, 0.f, 0.f, 0.f}; y2[j] = (u32x2){0u, 0u}; }
        if (mn < MT) LN_LOAD(v2, y2, mn);
        float s = 0.f;
#pragma unroll
        for (int j = 0; j < 8; ++j) { f32x4 yy; UNPK4(yy, y[j]); v[j] = v[j] * ALPHA_RES + yy; s += (v[j][0] + v[j][1]) + (v[j][2] + v[j][3]); }
        const float mean = wave_sum(s) * (1.f / DM); float s2 = 0.f;
#pragma unroll
        for (int j = 0; j < 8; ++j) { v[j] = v[j] - mean; s2 += (v[j][0] * v[j][0] + v[j][1] * v[j][1]) + (v[j][2] * v[j][2] + v[j][3] * v[j][3]); }
        const float rstd = rsqrtf(wave_sum(s2) * (1.f / DM) + 1e-5f);
        if (layer == 3) { float* row = hf + (size_t)m * DM + lane * 4;
#pragma unroll
            for (int j = 0; j < 8; ++j) { const f32x4 gg = *(const f32x4*)(g + j * 256 + lane * 4), bb = *(const f32x4*)(b + j * 256 + lane * 4); __builtin_nontemporal_store(v[j] * rstd * gg + bb, (f32x4*)(row + j * 256)); } }
        else { bf16_t* orow = hb + (size_t)m * DM + lane * 4;
#pragma unroll
            for (int j = 0; j < 8; ++j) { const f32x4 gg = *(const f32x4*)(g + j * 256 + lane * 4), bb = *(const f32x4*)(b + j * 256 + lane * 4); *(u32x2*)(orow + j * 256) = pack4(v[j] * rstd * gg + bb); } }
#pragma unroll
        for (int j = 0; j < 8; ++j) { v[j] = v2[j]; y[j] = y2[j]; }
        m = mn;
    }
#undef LN_LOAD
#undef UNPK4
}

__device__ __forceinline__ bf16x8 attn_ld8(bool samp, const bf16_t* proj, const float* cache, int jl, int b, int h, int t, int row, int col, int coloff) {
    bf16x8 r = {0, 0, 0, 0, 0, 0, 0, 0};
    if (!samp) return *(const bf16x8*)(proj + (size_t)(b * 8192 + t * 64 + row) * N4 + coloff + h * 128 + col);
    if (t < 8) { const float* s = cache + (size_t)((jl * 16 + b) * 512 + t * 64 + row) * DM + h * 128 + col; return pack8(*(const f32x4*)s, *(const f32x4*)(s + 4)); }
    if (row < 32) r = *(const bf16x8*)(proj + (size_t)(MPR + b * 32 + row) * N4 + coloff + h * 128 + col);
    return r;
}
__device__ __forceinline__ void attn_phase(unsigned char* lds, const Params& p, int jl, const bf16_t* proj, bf16_t* mix, int blk, int G, int tid) {
    bf16_t* KS = (bf16_t*)lds;
    bf16_t* VT = (bf16_t*)(lds + 34816);
    float* BIAS = (float*)(lds + 34816 + 36864);
    const int lane = tid & 63, w = tid >> 6, fr = lane & 15, fq = lane >> 4;
    for (int gi = blk * 512 + tid; gi < 2560 * 2 * 256; gi += G * 512) {
        const int c8 = gi & 255, kv = (gi >> 8) & 1, r = gi >> 9;
        size_t srow, dst;
        if (r < 2048) { const int b = r >> 9, tp = r & 511; srow = (size_t)b * 8192 + 7680 + tp; dst = (kv ? O_CVP : O_CKP) + ((size_t)(jl * 4 + b) * 512 + tp) * DM + c8 * 8; }
        else { const int rs = r - 2048; srow = (size_t)MPR + rs; dst = (kv ? O_CVS : O_CKS) + ((size_t)jl * 512 + rs) * DM + c8 * 8; }
        const bf16x8 x = *(const bf16x8*)(proj + srow * N4 + 2048 + kv * 2048 + c8 * 8);
        f32x4 a, b2;
#pragma unroll
        for (int j = 0; j < 4; ++j) { a[j] = bf2f(x[j]); b2[j] = bf2f(x[4 + j]); }
        *(f32x4*)(p.out + dst) = a; *(f32x4*)(p.out + dst + 4) = b2;
    }
    const float NEG_INF = -__builtin_inff();
    constexpr float SC2 = ATT_SCALE * 1.4426950408889634f;
    for (int u = blk; u < 256 + 2048; u += G) {
        const bool samp = u < 256;
        int b, h, qc4 = 0;
        if (samp) { b = u >> 4; h = u & 15; } else { const int v = u - 256; qc4 = v & 31; h = (v >> 5) & 15; b = v >> 9; }
        const int qrow0 = samp ? MPR + b * 32 : b * 8192 + qc4 * 256;
        const int t_lo = samp ? 0 : (4 * qc4 - 8 > 0 ? 4 * qc4 - 8 : 0), t_hi = samp ? 8 : 4 * qc4 + 3;
        const int cq = 4 * qc4 + (w >> 1);
        const int w_lo = samp ? 0 : cq - 8, w_hi = samp ? (w < 1 ? 8 : -1) : cq;
        const int qpos0 = samp ? 512 + fr : qc4 * 256 + w * 32 + fr;
        const float* kcache = p.ck_in; const float* vcache = p.cv_in;
        const bf16_t* pkbase = proj + (size_t)b * 8192 * N4 + 2048 + h * 128;
        for (int r_ = tid; r_ < 639; r_ += 512) { const int rel_ = 575 - r_; BIAS[r_] = p.rb[(jl * 16 + h) * 320 + (rel_ > 256 ? 256 : rel_) + 63] * 1.4426950408889634f; }
        const int qr = (samp && w >= 1) ? qrow0 + fr : qrow0 + w * 32 + fr;
        bf16x8 qf[2][4];
#pragma unroll
        for (int qt = 0; qt < 2; ++qt)
#pragma unroll
            for (int k4 = 0; k4 < 4; ++k4) qf[qt][k4] = *(const bf16x8*)(proj + (size_t)(qr + qt * 16) * N4 + h * 128 + k4 * 32 + fq * 8);
        f32x4 o[2][8];
#pragma unroll
        for (int qt = 0; qt < 2; ++qt)
#pragma unroll
            for (int dt = 0; dt < 8; ++dt) o[qt][dt] = (f32x4){0.f, 0.f, 0.f, 0.f};
        float m_run[2] = {-1e30f, -1e30f}, l_run[2] = {0.f, 0.f};
        bf16x8 kc0, kc1, vc0, vc1;
#define ATT_LOADT(t) do { int tl_ = tid; asm volatile("" : "+v"(tl_)); const int krow_ = tl_ >> 4, kcc_ = tl_ & 15, vkey_ = tl_ & 63, vdc_ = tl_ >> 6; \
        if (!samp) { const bf16_t* kt_ = pkbase + (size_t)(t) * (64 * N4); const unsigned ko_ = (unsigned)(krow_ * N4 + kcc_ * 8), vo_ = (unsigned)(vkey_ * N4 + 2048 + vdc_ * 8); \
            kc0 = *(const bf16x8*)(kt_ + ko_); kc1 = *(const bf16x8*)(kt_ + (ko_ + 32u * N4)); vc0 = *(const bf16x8*)(kt_ + vo_); vc1 = *(const bf16x8*)(kt_ + (vo_ + 64u)); } \
        else { kc0 = attn_ld8(samp, proj, kcache, jl, b, h, (t), krow_, kcc_ * 8, 2048); kc1 = attn_ld8(samp, proj, kcache, jl, b, h, (t), krow_ + 32, kcc_ * 8, 2048); \
            vc0 = attn_ld8(samp, proj, vcache, jl, b, h, (t), vkey_, vdc_ * 8, 4096); vc1 = attn_ld8(samp, proj, vcache, jl, b, h, (t), vkey_, (vdc_ + 8) * 8, 4096); } } while (0)
#define ATT_WRITET(bf) do { int tl_ = tid; asm volatile("" : "+v"(tl_)); const int krow_ = tl_ >> 4, kcc_ = tl_ & 15, vkey_ = tl_ & 63, vdc_ = tl_ >> 6; \
        bf16_t* ks_ = KS + (bf) * (64 * 136) + krow_ * 136 + kcc_ * 8; bf16_t* vt_ = VT + (bf) * (128 * 72) + vdc_ * 8 * 72 + vkey_; \
        *(bf16x8*)ks_ = kc0; *(bf16x8*)(ks_ + 32 * 136) = kc1; \
        _Pragma("unroll") for (int e = 0; e < 8; ++e) { vt_[e * 72] = (bf16_t)vc0[e]; vt_[(64 + e) * 72] = (bf16_t)vc1[e]; } } while (0)
        ATT_LOADT(t_lo);
        ATT_WRITET(0);
        __syncthreads();
        const int nt = t_hi - t_lo + 1;
        for (int i = 0; i < nt; ++i) {
            const int t = t_lo + i, buf = i & 1;
            if (i + 1 < nt) ATT_LOADT(t + 1);
            if (t >= w_lo && t <= w_hi) {
                const bf16_t* ks = KS + buf * (64 * 136); const bf16_t* vt = VT + buf * (128 * 72);
                const int nvk = (samp && t == 8) ? 32 : 64;
                f32x4 s[2][4];
#pragma unroll
                for (int qt = 0; qt < 2; ++qt)
#pragma unroll
                    for (int kt = 0; kt < 4; ++kt) s[qt][kt] = (f32x4){0.f, 0.f, 0.f, 0.f};
#pragma unroll
                for (int kh2 = 0; kh2 < 2; ++kh2) { bf16x8 kf[2][4];
#pragma unroll
                    for (int kt = 0; kt < 2; ++kt)
#pragma unroll
                        for (int k4 = 0; k4 < 4; ++k4) kf[kt][k4] = *(const bf16x8*)(ks + ((kh2 * 2 + kt) * 16 + fr) * 136 + k4 * 32 + fq * 8);
                    __builtin_amdgcn_sched_barrier(0);
#pragma unroll
                    for (int k4 = 0; k4 < 4; ++k4)
#pragma unroll
                        for (int kt = 0; kt < 2; ++kt)
#pragma unroll
                            for (int qt = 0; qt < 2; ++qt) s[qt][kh2 * 2 + kt] = MFMA16(kf[kt][k4], qf[qt][k4], s[qt][kh2 * 2 + kt]);
                    __builtin_amdgcn_sched_barrier(0); }
                bf16x8 vf[4][2][2];
#define ATT_VLOAD(g4) do { _Pragma("unroll") for (int d = 0; d < 2; ++d) _Pragma("unroll") for (int k2 = 0; k2 < 2; ++k2) { const bf16_t* vp = vt + (((g4) * 2 + d) * 16 + fr) * 72 + k2 * 32 + fq * 4; \
                    vf[g4][d][k2] = cat8(*(const bf16x4*)vp, *(const bf16x4*)(vp + 16)); } } while (0)
#define ATT_VMMA(g4) do { _Pragma("unroll") for (int k2 = 0; k2 < 2; ++k2) _Pragma("unroll") for (int d = 0; d < 2; ++d) _Pragma("unroll") for (int qt = 0; qt < 2; ++qt) \
                    o[qt][(g4) * 2 + d] = MFMA16(vf[g4][d][k2], pb[qt][k2], o[qt][(g4) * 2 + d]); } while (0)
                ATT_VLOAD(0);
                __builtin_amdgcn_sched_barrier(0);
                bf16x8 pb[2][2];
#pragma unroll
                for (int qt = 0; qt < 2; ++qt) {
                    const float* bp = BIAS + (575 - (qpos0 + qt * 16 - t * 64 - fq * 4));
#pragma unroll
                    for (int kt = 0; kt < 4; ++kt) { const f32x4 bv = {bp[kt * 16], bp[kt * 16 + 1], bp[kt * 16 + 2], bp[kt * 16 + 3]}; s[qt][kt] = s[qt][kt] * SC2 + bv; }
                    if (nvk < 64) {
#pragma unroll
                        for (int kt = 0; kt < 4; ++kt)
#pragma unroll
                            for (int j = 0; j < 4; ++j) if (kt * 16 + fq * 4 + j >= nvk) s[qt][kt][j] = NEG_INF; }
                    float mx;
                    { const f32x4 m01 = __builtin_elementwise_max(s[qt][0], s[qt][1]), m23 = __builtin_elementwise_max(s[qt][2], s[qt][3]), m4 = __builtin_elementwise_max(m01, m23);
                      mx = fmaxf(fmaxf(m4[0], m4[1]), fmaxf(m4[2], m4[3])); }
                    mx = fmaxf(mx, __shfl_xor(mx, 16)); mx = fmaxf(mx, __shfl_xor(mx, 32));
                    const float m_new = fmaxf(m_run[qt], mx), alpha = __builtin_amdgcn_exp2f(m_run[qt] - m_new);
#pragma unroll
                    for (int kt = 0; kt < 4; ++kt) { s[qt][kt] = s[qt][kt] - m_new;
#pragma unroll
                        for (int j = 0; j < 4; ++j) s[qt][kt][j] = __builtin_amdgcn_exp2f(s[qt][kt][j]); }
                    const f32x4 sv4 = (s[qt][0] + s[qt][1]) + (s[qt][2] + s[qt][3]);
                    const float ps = (sv4[0] + sv4[1]) + (sv4[2] + sv4[3]);
                    l_run[qt] = l_run[qt] * alpha + ps; m_run[qt] = m_new;
                    if (__any(alpha != 1.f)) {
#pragma unroll
                        for (int dt = 0; dt < 8; ++dt) o[qt][dt] = o[qt][dt] * alpha; }
                    pb[qt][0] = pack8(s[qt][0], s[qt][1]); pb[qt][1] = pack8(s[qt][2], s[qt][3]);
                }
                __builtin_amdgcn_sched_barrier(0);
                ATT_VLOAD(1); ATT_VMMA(0);
                __builtin_amdgcn_sched_barrier(0);
                ATT_VLOAD(2); ATT_VMMA(1);
                __builtin_amdgcn_sched_barrier(0);
                ATT_VLOAD(3); ATT_VMMA(2);
                __builtin_amdgcn_sched_barrier(0);
                ATT_VMMA(3);
#undef ATT_VLOAD
#undef ATT_VMMA
            }
            if (i + 1 < nt) ATT_WRITET(buf ^ 1);
            __syncthreads();
        }
#undef ATT_LOADT
#undef ATT_WRITET
#pragma unroll
        for (int qt = 0; qt < 2; ++qt) {
            float l = l_run[qt]; l += __shfl_xor(l, 16); l += __shfl_xor(l, 32);
            if (!samp || w < 1) {
                const float inv = 1.f / l; const int row = qrow0 + (samp ? 0 : w * 32) + qt * 16 + fr;
                const bf16_t* gp = proj + (size_t)row * N4 + 6144 + h * 128 + fq * 4; bf16_t* mp = mix + (size_t)row * DM + h * 128 + fq * 4;
#pragma unroll
                for (int dt = 0; dt < 8; ++dt) { const bf16x4 gv = *(const bf16x4*)(gp + dt * 16); f32x4 ov;
#pragma unroll
                    for (int j = 0; j < 4; ++j) { const float gg = bf2f(gv[j]); ov[j] = o[qt][dt][j] * inv * (gg * __builtin_amdgcn_rcpf(1.f + fexp(-gg))); }
                    *(u32x2*)(mp + dt * 16) = pack4(ov); }
            }
        }
    }
}
__device__ __forceinline__ void hgrn_a(unsigned char* lds, const Params& p, int jl, bf16_t* proj, bf16_t* mix, float* dbuf, bf16_t* scr, float* useg, float* dseg, int blk, int G, int tid) {
    bf16_t* RAWQ = (bf16_t*)lds;
    bf16_t* RAWZ = (bf16_t*)(lds + 17408);
    bf16_t* QT   = (bf16_t*)(lds + 34816);
    bf16_t* KTL  = (bf16_t*)(lds + 52224);
    bf16_t* VTL  = (bf16_t*)(lds + 69632);
    float*  TOT  = (float*)(lds + 88064);
    bf16_t* KHT  = (bf16_t*)(lds + 90112);
    float*  DLS  = (float*)(lds + 108544);
    const int lane = tid & 63, w = tid >> 6, fr = lane & 15, fq = lane >> 4;
    const int c = tid & 127, tg = tid >> 7;
    if (w >= 4) __builtin_amdgcn_s_setprio(1);
    for (int u = blk; u < 512; u += G) {
        const bool samp = u >= 256;
        int b, h, chunk0 = 0, nch;
        if (!samp) { b = u >> 6; h = (u >> 2) & 15; chunk0 = b * 128 + (u & 3) * 32; nch = 32; } else { const int su = u - 256; b = su >> 4; h = su & 15; nch = 1; }
        const int nvalid = samp ? 32 : 64;
        const int ch = h * 128 + c;
        float lb = 0.f;
        if (jl == 1) { const float a0 = p.lb[ch], a1 = p.lb[2048 + ch]; lb = 1.f / (1.f + fexp(a0 - a1)); }
        const float lbe = fmaxf(lb, 1e-30f), oml = 1.f - lb;
        f32x4 U[8];
#pragma unroll
        for (int kti = 0; kti < 8; ++kti) U[kti] = (f32x4){0.f, 0.f, 0.f, 0.f};
        float bsum = 0.f;
        const int lrow = tid >> 4, lcc = tid & 15, vkey = tid & 63, vdc = tid >> 6;
        bf16x8 rq0, rq1, rz0, rz1, rv0, rv1;
        const bf16x8 zero8 = {0, 0, 0, 0, 0, 0, 0, 0};
#define HA_LOAD(n) do { const bf16_t* s_ = proj + (size_t)(samp ? MPR + b * 32 : (chunk0 + (n)) * 64) * N4 + h * 128; \
        rq0 = rq1 = rz0 = rz1 = rv0 = rv1 = zero8; \
        if (lrow < nvalid) { rq0 = *(const bf16x8*)(s_ + (size_t)lrow * N4 + lcc * 8); rz0 = *(const bf16x8*)(s_ + (size_t)lrow * N4 + 2048 + lcc * 8); } \
        if (lrow + 32 < nvalid) { rq1 = *(const bf16x8*)(s_ + (size_t)(lrow + 32) * N4 + lcc * 8); rz1 = *(const bf16x8*)(s_ + (size_t)(lrow + 32) * N4 + 2048 + lcc * 8); } \
        if (vkey < nvalid) { rv0 = *(const bf16x8*)(s_ + (size_t)vkey * N4 + 4096 + vdc * 8); rv1 = *(const bf16x8*)(s_ + (size_t)vkey * N4 + 4096 + (vdc + 8) * 8); } } while (0)
        HA_LOAD(0);
        for (int n = 0; n < nch; ++n) {
            int row0, didx, dstride; bf16_t *qd, *kd, *vd;
            if (!samp) { row0 = (chunk0 + n) * 64; didx = chunk0 + n; bf16_t* base = proj + (size_t)row0 * N4 + h * 128; qd = base; kd = base + 2048; vd = base + 4096; dstride = N4; }
            else { row0 = MPR + b * 32; didx = 512 + b; bf16_t* base = scr + (size_t)(u - 256) * 3 * 8192; qd = base; kd = base + 8192; vd = base + 16384; dstride = 128; }
            *(bf16x8*)(RAWQ + lrow * 136 + lcc * 8) = rq0; *(bf16x8*)(RAWQ + (lrow + 32) * 136 + lcc * 8) = rq1;
            *(bf16x8*)(RAWZ + lrow * 136 + lcc * 8) = rz0; *(bf16x8*)(RAWZ + (lrow + 32) * 136 + lcc * 8) = rz1;
#pragma unroll
            for (int e = 0; e < 8; ++e) { VTL[(vdc * 8 + e) * 72 + vkey] = (bf16_t)rv0[e]; VTL[((vdc + 8) * 8 + e) * 72 + vkey] = (bf16_t)rv1[e]; }
            if (n + 1 < nch) HA_LOAD(n + 1);
            __syncthreads();
            float cum[16], kk[16], qs[16]; float run = 0.f;
#pragma unroll
            for (int i = 0; i < 16; ++i) { const int tok = tg * 16 + i; const float q = bf2f((short)RAWQ[tok * 136 + c]), z = bf2f((short)RAWZ[tok * 136 + c]);
                const float e = fexp(-fabsf(z)), r = __builtin_amdgcn_rcpf(1.f + e), er = e * r; const float sp = z >= 0.f ? r : er, sn = z >= 0.f ? er : r;
                float lf = flog(sp + lbe * sn), kv = oml * sn, qq = q * __builtin_amdgcn_rcpf(1.f + fexp(-q));
                if (nvalid < 64) { if (tok >= nvalid) { lf = 0.f; kv = 0.f; qq = 0.f; } }
                run += lf; cum[i] = run; kk[i] = kv; qs[i] = qq; }
            TOT[tg * 128 + c] = run;
            __syncthreads();
            const float t0 = TOT[c], t1 = TOT[128 + c], t2 = TOT[256 + c], t3 = TOT[384 + c];
            const float off = (tg > 0 ? t0 : 0.f) + (tg > 1 ? t1 : 0.f) + (tg > 2 ? t2 : 0.f), bend = (t0 + t1) + (t2 + t3), bref = t0 + t1;
            const float eref = fexp(bref), eend = fexp(bend - bref);
            float kh[16];
#pragma unroll
            for (int i = 0; i < 16; ++i) { const int tok = tg * 16 + i; const float bt = off + cum[i];
                const float e1 = fexp(bt - bref), e2 = fexp(bref - bt);
                const float qt = qs[i] * e1, kt2 = kk[i] * e2, qh = qt * eref; kh[i] = kt2 * eend;
                QT[tok * 136 + c] = f2bf(qt); KTL[tok * 136 + c] = f2bf(kt2); qd[(size_t)tok * dstride + c] = f2bf(qh); }
            { u32x4 w0, w1; w0.x = pk2(kh[0], kh[1]); w0.y = pk2(kh[2], kh[3]); w0.z = pk2(kh[4], kh[5]); w0.w = pk2(kh[6], kh[7]);
              w1.x = pk2(kh[8], kh[9]); w1.y = pk2(kh[10], kh[11]); w1.z = pk2(kh[12], kh[13]); w1.w = pk2(kh[14], kh[15]);
              bf16_t* kp = kd + (size_t)(c >> 1) * dstride + (c & 1) * 64 + tg * 16; *(u32x4*)kp = w0; *(u32x4*)(kp + 8) = w1;
              *(u32x4*)(KHT + c * 72 + tg * 16) = w0; *(u32x4*)(KHT + c * 72 + tg * 16 + 8) = w1; }
            if (tg == 0) { const float dd = fexp(bend); dbuf[(size_t)didx * DM + ch] = dd; DLS[c] = dd; bsum += bend; }
            __syncthreads();
            const int tt = w & 3, vh = w >> 2;
            f32x4 pm[4];
            __builtin_amdgcn_sched_barrier(0);
            { bf16x8 qfr[4];
#pragma unroll
              for (int k4 = 0; k4 < 4; ++k4) qfr[k4] = *(const bf16x8*)(QT + (tt * 16 + fr) * 136 + k4 * 32 + fq * 8);
#pragma unroll
              for (int sh = 0; sh < 2; ++sh) { bf16x8 kfr[2][4];
#pragma unroll
                  for (int s2 = 0; s2 < 2; ++s2)
#pragma unroll
                      for (int k4 = 0; k4 < 4; ++k4) kfr[s2][k4] = *(const bf16x8*)(KTL + ((sh * 2 + s2) * 16 + fr) * 136 + k4 * 32 + fq * 8);
                  __builtin_amdgcn_sched_barrier(0);
#pragma unroll
                  for (int s2 = 0; s2 < 2; ++s2) { const int st = sh * 2 + s2; pm[st] = (f32x4){0.f, 0.f, 0.f, 0.f};
#pragma unroll
                      for (int k4 = 0; k4 < 4; ++k4) pm[st] = MFMA16(kfr[s2][k4], qfr[k4], pm[st]);
#pragma unroll
                      for (int j = 0; j < 4; ++j) { const bool keep = (st < tt) || (st == tt && fq * 4 + j <= fr); pm[st][j] = keep ? pm[st][j] : 0.f; } }
                  __builtin_amdgcn_sched_barrier(0); } }
            bf16x8 pb[2]; pb[0] = pack8(pm[0], pm[1]); pb[1] = pack8(pm[2], pm[3]);
            f32x4 oo[4];
            { bf16x8 vfr[4][2];
#pragma unroll
              for (int vt = 0; vt < 4; ++vt)
#pragma unroll
                  for (int k2 = 0; k2 < 2; ++k2) { const bf16_t* vp = VTL + ((vh * 4 + vt) * 16 + fr) * 72 + k2 * 32 + fq * 4; vfr[vt][k2] = cat8(*(const bf16x4*)vp, *(const bf16x4*)(vp + 16)); }
              __builtin_amdgcn_sched_barrier(0);
#pragma unroll
              for (int vt = 0; vt < 4; ++vt) { oo[vt] = (f32x4){0.f, 0.f, 0.f, 0.f};
#pragma unroll
                  for (int k2 = 0; k2 < 2; ++k2) oo[vt] = MFMA16(vfr[vt][k2], pb[k2], oo[vt]); } }
            { const int tok = tt * 16 + fr;
              if (tok < nvalid) { bf16_t* mp = mix + (size_t)(row0 + tok) * DM + h * 128 + vh * 64 + fq * 4;
#pragma unroll
                  for (int vt = 0; vt < 4; ++vt) *(u32x2*)(mp + vt * 16) = pack4(oo[vt]); } }
#pragma unroll
            for (int i = 0; i < 2; ++i) { const int cidx = tid + 512 * i, v = cidx >> 3, sc = cidx & 7; const bf16x8 x = *(const bf16x8*)(VTL + v * 72 + sc * 8);
                *(bf16x8*)(vd + (size_t)(v >> 1) * dstride + (v & 1) * 64 + sc * 8) = x; }
            __builtin_amdgcn_sched_barrier(0);
            if (!samp) { bf16x8 vb[2];
#pragma unroll
                for (int ks = 0; ks < 2; ++ks) vb[ks] = *(const bf16x8*)(VTL + (w * 16 + fr) * 72 + ks * 32 + fq * 8);
#pragma unroll
                for (int kh2 = 0; kh2 < 2; ++kh2) { bf16x8 kf[4][2]; f32x4 dv[4];
#pragma unroll
                    for (int k3 = 0; k3 < 4; ++k3) { dv[k3] = *(const f32x4*)(DLS + (kh2 * 4 + k3) * 16 + fq * 4);
#pragma unroll
                        for (int ks = 0; ks < 2; ++ks) kf[k3][ks] = *(const bf16x8*)(KHT + ((kh2 * 4 + k3) * 16 + fr) * 72 + ks * 32 + fq * 8); }
                    __builtin_amdgcn_sched_barrier(0);
#pragma unroll
                    for (int k3 = 0; k3 < 4; ++k3) U[kh2 * 4 + k3] = U[kh2 * 4 + k3] * dv[k3];
#pragma unroll
                    for (int ks = 0; ks < 2; ++ks)
#pragma unroll
                        for (int k3 = 0; k3 < 4; ++k3) U[kh2 * 4 + k3] = MFMA16(kf[k3][ks], vb[ks], U[kh2 * 4 + k3]);
                    __builtin_amdgcn_sched_barrier(0); } }
            __syncthreads();
        }
#undef HA_LOAD
        if (!samp) {
            int loff = fq * 512 + w * 16 + fr; asm volatile("" : "+v"(loff));
            float* ud = useg + (size_t)u * 16384 + loff;
#pragma unroll
            for (int kti = 0; kti < 8; ++kti)
#pragma unroll
                for (int j = 0; j < 4; ++j) ud[(kti * 16 + j) * 128] = U[kti][j];
            if (tg == 0) dseg[u * 128 + c] = fexp(bsum);
        }
    }
    __builtin_amdgcn_s_setprio(0);
}

__device__ __forceinline__ void hgrn_b(unsigned char* lds, const Params& p, int jl, const bf16_t* proj, bf16_t* mix, const float* dbuf, const bf16_t* scr, const float* useg, const float* dseg, int blk, int G, int tid) {
    bf16_t* QH = (bf16_t*)lds;
    bf16_t* KT = (bf16_t*)(lds + 34816);
    bf16_t* VT = (bf16_t*)(lds + 71680);
    float* DL = (float*)(lds + 108544);
    float* PART = (float*)(lds + 109568);
    const int lane = tid & 63, w = tid >> 6, fr = lane & 15, fq = lane >> 4;
    if (w >= 4) __builtin_amdgcn_s_setprio(1);
    for (int u = blk; u < 512; u += G) {
        const bool samp = u >= 256;
        int b, h, seg = 0, sidx = 0;
        if (!samp) { b = u >> 6; h = (u >> 2) & 15; seg = u & 3; } else { sidx = u - 256; b = sidx >> 4; h = sidx & 15; }
        const int nch = samp ? 1 : 32, row0 = samp ? MPR + b * 32 : b * 8192 + seg * 2048, nvalid = samp ? 32 : 64;
        const bf16_t* tq; const bf16_t* tk; const bf16_t* tv; size_t rstride, cstep;
        if (!samp) { const bf16_t* base = proj + (size_t)row0 * N4 + h * 128; tq = base; tk = base + 2048; tv = base + 4096; rstride = N4; cstep = (size_t)64 * N4; }
        else { const bf16_t* base = scr + (size_t)sidx * 3 * 8192; tq = base; tk = base + 8192; tv = base + 16384; rstride = 128; cstep = 0; }
        const float* dsrc = dbuf + (size_t)(samp ? 512 + b : b * 128 + seg * 32) * DM + h * 128;
        const f32x4 ngv = *(const f32x4*)(p.ng + jl * DM + h * 128 + w * 16 + fq * 4);
        bf16x8 rq0, rq1, rk0, rk1, rv0, rv1; f32x4 rd = {0.f, 0.f, 0.f, 0.f};
        const int lrow = tid >> 4, lcc = tid & 15;
#define SEQ_LOAD(n) do { const size_t o0_ = (size_t)(n) * cstep + (size_t)lrow * rstride + lcc * 8, o1_ = o0_ + 32 * rstride; \
        rq0 = *(const bf16x8*)(tq + o0_); rq1 = *(const bf16x8*)(tq + o1_); rk0 = *(const bf16x8*)(tk + o0_); rk1 = *(const bf16x8*)(tk + o1_); \
        rv0 = *(const bf16x8*)(tv + o0_); rv1 = *(const bf16x8*)(tv + o1_); if (tid < 32) rd = *(const f32x4*)(dsrc + (size_t)(n) * DM + tid * 4); } while (0)
#define SEQ_WRITE(bf) do { bf16_t* q_ = QH + (bf) * (64 * 136); bf16_t* k_ = KT + (bf) * (128 * 72); bf16_t* v_ = VT + (bf) * (128 * 72); \
        *(bf16x8*)(q_ + lrow * 136 + lcc * 8) = rq0; *(bf16x8*)(q_ + (lrow + 32) * 136 + lcc * 8) = rq1; \
        const int kk0_ = 2 * lrow + (lcc >> 3), so_ = (lcc & 7) * 8; \
        *(bf16x8*)(k_ + kk0_ * 72 + so_) = rk0; *(bf16x8*)(k_ + (kk0_ + 64) * 72 + so_) = rk1; *(bf16x8*)(v_ + kk0_ * 72 + so_) = rv0; *(bf16x8*)(v_ + (kk0_ + 64) * 72 + so_) = rv1; \
        if (tid < 32) *(f32x4*)(DL + (bf) * 128 + tid * 4) = rd; } while (0)
        SEQ_LOAD(0);
        f32x4 S[8];
#pragma unroll
        for (int kti = 0; kti < 8; ++kti)
#pragma unroll
            for (int j = 0; j < 4; ++j) S[kti][j] = samp ? p.st_in[(size_t)((jl * 16 + b) * 16 + h) * 16384 + (kti * 16 + fq * 4 + j) * 128 + w * 16 + fr] : 0.f;
        for (int sj = 0; sj < seg; ++sj) { const float* Uj = useg + (size_t)(u - seg + sj) * 16384 + w * 16 + fr; const float* Dj = dseg + (u - seg + sj) * 128;
#pragma unroll
            for (int kti = 0; kti < 8; ++kti) { const f32x4 dv = *(const f32x4*)(Dj + kti * 16 + fq * 4);
#pragma unroll
                for (int j = 0; j < 4; ++j) S[kti][j] = S[kti][j] * dv[j] + Uj[(kti * 16 + fq * 4 + j) * 128]; } }
        SEQ_WRITE(0);
        __syncthreads();
        for (int n = 0; n < nch; ++n) {
            const int buf = n & 1;
            if (n + 1 < nch) SEQ_LOAD(n + 1);
            u32x2 oin[4], gin[4];
#pragma unroll
            for (int tt = 0; tt < 4; ++tt) { const int tok = tt * 16 + fr; oin[tt] = (u32x2){0u, 0u}; gin[tt] = (u32x2){0u, 0u};
                if (tok < nvalid) { const size_t row = (size_t)row0 + (size_t)n * 64 + tok;
                    oin[tt] = *(const u32x2*)(mix + row * DM + h * 128 + w * 16 + fq * 4); gin[tt] = *(const u32x2*)(proj + row * N4 + 6144 + h * 128 + w * 16 + fq * 4); } }
            const bf16_t* qh = QH + buf * (64 * 136); const bf16_t* kt = KT + buf * (128 * 72); const bf16_t* vt = VT + buf * (128 * 72); const float* dl = DL + buf * 128;
            f32x4 oT[4];
            { bf16x8 sa[4];
#pragma unroll
              for (int k2 = 0; k2 < 4; ++k2) sa[k2] = pack8(S[2 * k2], S[2 * k2 + 1]);
#pragma unroll
              for (int th = 0; th < 2; ++th) { bf16x8 qfr[2][4];
#pragma unroll
                  for (int t2 = 0; t2 < 2; ++t2)
#pragma unroll
                      for (int k2 = 0; k2 < 4; ++k2) { const bf16_t* qp = qh + ((th * 2 + t2) * 16 + fr) * 136 + k2 * 32 + fq * 4; qfr[t2][k2] = cat8(*(const bf16x4*)qp, *(const bf16x4*)(qp + 16)); }
                  __builtin_amdgcn_sched_barrier(0);
#pragma unroll
                  for (int t2 = 0; t2 < 2; ++t2) oT[th * 2 + t2] = (f32x4){0.f, 0.f, 0.f, 0.f};
#pragma unroll
                  for (int k2 = 0; k2 < 4; ++k2)
#pragma unroll
                      for (int t2 = 0; t2 < 2; ++t2) oT[th * 2 + t2] = MFMA16(sa[k2], qfr[t2][k2], oT[th * 2 + t2]);
                  __builtin_amdgcn_sched_barrier(0); } }
            { bf16x8 vb[2];
#pragma unroll
              for (int ks = 0; ks < 2; ++ks) vb[ks] = *(const bf16x8*)(vt + (w * 16 + fr) * 72 + ks * 32 + fq * 8);
#pragma unroll
              for (int kh2 = 0; kh2 < 2; ++kh2) { bf16x8 kf[4][2]; f32x4 dv[4];
#pragma unroll
                  for (int k3 = 0; k3 < 4; ++k3) { dv[k3] = *(const f32x4*)(dl + (kh2 * 4 + k3) * 16 + fq * 4);
#pragma unroll
                      for (int ks = 0; ks < 2; ++ks) kf[k3][ks] = *(const bf16x8*)(kt + ((kh2 * 4 + k3) * 16 + fr) * 72 + ks * 32 + fq * 8); }
                  __builtin_amdgcn_sched_barrier(0);
#pragma unroll
                  for (int k3 = 0; k3 < 4; ++k3) S[kh2 * 4 + k3] = S[kh2 * 4 + k3] * dv[k3];
#pragma unroll
                  for (int ks = 0; ks < 2; ++ks)
#pragma unroll
                      for (int k3 = 0; k3 < 4; ++k3) S[kh2 * 4 + k3] = MFMA16(kf[k3][ks], vb[ks], S[kh2 * 4 + k3]);
                  __builtin_amdgcn_sched_barrier(0); } }
#pragma unroll
            for (int tt = 0; tt < 4; ++tt) { float ss = 0.f;
#pragma unroll
                for (int j = 0; j < 4; ++j) { const unsigned wv = oin[tt][j >> 1]; const float oi = __uint_as_float((j & 1) ? (wv & 0xffff0000u) : (wv << 16)); const float ov = oT[tt][j] + oi; oT[tt][j] = ov; ss += ov * ov; }
                ss += __shfl_xor(ss, 16); ss += __shfl_xor(ss, 32);
                if (fq == 0) PART[(tt * 16 + fr) * 8 + w] = ss; }
            __syncthreads();
#pragma unroll
            for (int tt = 0; tt < 4; ++tt) { const int tok = tt * 16 + fr; const float* pp = PART + tok * 8; const f32x4 pa = *(const f32x4*)pp, pb2 = *(const f32x4*)(pp + 4);
                const float tot = ((pa[0] + pa[1]) + (pa[2] + pa[3])) + ((pb2[0] + pb2[1]) + (pb2[2] + pb2[3]));
                const float rstd = rsqrtf(tot * (1.f / 128.f) + 1e-6f); f32x4 ov;
#pragma unroll
                for (int j = 0; j < 4; ++j) { const unsigned wv = gin[tt][j >> 1]; const float gg = __uint_as_float((j & 1) ? (wv & 0xffff0000u) : (wv << 16)); ov[j] = oT[tt][j] * rstd * ngv[j] * (gg * __builtin_amdgcn_rcpf(1.f + fexp(-gg))); }
                if (tok < nvalid) *(u32x2*)(mix + ((size_t)row0 + (size_t)n * 64 + tok) * DM + h * 128 + w * 16 + fq * 4) = pack4(ov); }
            if (n + 1 < nch) SEQ_WRITE(buf ^ 1);
            __syncthreads();
        }
#undef SEQ_LOAD
#undef SEQ_WRITE
        if (samp || seg == 3) {
            float* sdst = p.out + (samp ? O_STS + (size_t)((jl * 16 + b) * 16 + h) * 16384 : O_STP + (size_t)((jl * 4 + b) * 16 + h) * 16384);
            int loff = fq * 512 + w * 16 + fr; asm volatile("" : "+v"(loff));
            sdst += loff;
#pragma unroll
            for (int kti = 0; kti < 8; ++kti)
#pragma unroll
                for (int j = 0; j < 4; ++j) sdst[(kti * 16 + j) * 128] = S[kti][j];
        }
    }
    __builtin_amdgcn_s_setprio(0);
}
__device__ __forceinline__ void grid_bar(unsigned* bar, unsigned target, int tid) {
    asm volatile("s_waitcnt vmcnt(0)" ::: "memory");
    __syncthreads();
    if (tid == 0) {
        __builtin_amdgcn_fence(__ATOMIC_RELEASE, "agent");
        asm volatile("s_waitcnt vmcnt(0)" ::: "memory");
        __hip_atomic_fetch_add(bar, 1u, __ATOMIC_RELAXED, __HIP_MEMORY_SCOPE_AGENT);
        while (__hip_atomic_load(bar, __ATOMIC_RELAXED, __HIP_MEMORY_SCOPE_AGENT) < target) __builtin_amdgcn_s_sleep(1);
        __builtin_amdgcn_fence(__ATOMIC_ACQUIRE, "agent");
        asm volatile("s_waitcnt vmcnt(0)" ::: "memory");
    }
    __syncthreads();
}

typedef __attribute__((address_space(1))) unsigned gu32;
#define XB_TMO      128
#define XB_XCNT(j)  (256  + 64 * (j))
#define XB_XSUB(j)  (1280 + 64 * (j))
#define XB_XGEN(j)  (2304 + 64 * (j))
#define XB_TOP      3328
#define XB_TOPGEN   3392
#define XCD_BAR_WORDS 3456
#define XB_SPIN_CAP (1u << 18)

__device__ __forceinline__ unsigned xb_ld(unsigned* p)              { return __hip_atomic_load(p, __ATOMIC_RELAXED, __HIP_MEMORY_SCOPE_AGENT); }
__device__ __forceinline__ unsigned xb_add(unsigned* p, unsigned v) { return __hip_atomic_fetch_add(p, v, __ATOMIC_RELAXED, __HIP_MEMORY_SCOPE_AGENT); }
__device__ __forceinline__ unsigned xb_xcc_id() { return (unsigned)__builtin_amdgcn_s_getreg((3 << 11) | 20) & 0xFu; }
#define XB_SPIN(cond, bar) do { unsigned _sp = 0; while (cond) { __builtin_amdgcn_s_sleep(1); \
    if ((++_sp & 255u) == 0u) { if (xb_ld(&(bar)[XB_TMO])) break; if (_sp > XB_SPIN_CAP) { atomicAdd(&(bar)[XB_TMO], 1u); break; } } } } while (0)

struct XcdBarrier {
    unsigned* bar; unsigned x;
    volatile LAS unsigned* st;
};

__device__ __forceinline__ XcdBarrier xcd_barrier_post(unsigned* bar, volatile LAS unsigned* st) {
    XcdBarrier b; b.bar = bar; b.x = xb_xcc_id(); b.st = st;
    if (threadIdx.x == 0) (void)xb_add(&bar[XB_XCNT(b.x)], 1u);
    return b;
}
__device__ __forceinline__ void xcd_barrier_complete(unsigned* bar, unsigned x, unsigned& nloc, unsigned& nx) {
    const unsigned G = gridDim.x * gridDim.y * gridDim.z;
    unsigned sum, cnt, mine, sp = 0u;
    for (;;) {
        sum = 0u; cnt = 0u; mine = 0u;
#pragma unroll
        for (unsigned j = 0; j < 16; ++j) { const unsigned c = xb_ld(&bar[XB_XCNT(j)]); sum += c; cnt += (c > 0u) ? 1u : 0u; mine = (j == x) ? c : mine; }
        if (sum == G) break;
        __builtin_amdgcn_s_sleep(1);
        if ((++sp & 255u) == 0u) { if (xb_ld(&bar[XB_TMO])) break; if (sp > XB_SPIN_CAP) { atomicAdd(&bar[XB_TMO], 1u); break; } }
    }
    nloc = mine > 0u ? mine : 1u; nx = cnt > 0u ? cnt : 1u;
}

__device__ __forceinline__ void xcd_barrier(const XcdBarrier& b) {
    asm volatile("s_waitcnt vmcnt(0)" ::: "memory");
    __syncthreads();
    if (threadIdx.x == 0) {
        unsigned* bar = b.bar;
        __builtin_amdgcn_s_waitcnt(0);
        unsigned nloc = b.st[0], nx = b.st[1];
        if (nloc == 0u) { xcd_barrier_complete(bar, b.x, nloc, nx); b.st[0] = nloc; b.st[1] = nx; }
        const unsigned old = xb_add(&bar[XB_XSUB(b.x)], 1u);
        const unsigned gen = old / nloc;
        if (old + 1u == (gen + 1u) * nloc) {
            __builtin_amdgcn_fence(__ATOMIC_RELEASE, "agent");
            asm volatile("s_waitcnt vmcnt(0)" ::: "memory");
            const unsigned og = xb_add(&bar[XB_TOP], 1u);
            const unsigned tg = og / nx;
            if (og + 1u == (tg + 1u) * nx) xb_add(&bar[XB_TOPGEN], 1u);
            else XB_SPIN(xb_ld(&bar[XB_TOPGEN]) == tg, bar);
            __builtin_amdgcn_fence(__ATOMIC_ACQUIRE, "agent");
            xb_add(&bar[XB_XGEN(b.x)], 1u);
            asm volatile("s_waitcnt vmcnt(0)" ::: "memory");
        } else {
            XB_SPIN(xb_ld(&bar[XB_XGEN(b.x)]) == gen, bar);
            __builtin_amdgcn_fence(__ATOMIC_ACQUIRE, "agent");
            asm volatile("s_waitcnt vmcnt(0)" ::: "memory");
        }
    }
    __syncthreads();
}

__global__ void __launch_bounds__(512, 2) fwd_kernel(Params p) {
    extern __shared__ __attribute__((aligned(16))) unsigned char lds[];
    const int wave_s = __builtin_amdgcn_readfirstlane((int)(threadIdx.x >> 6));
    const int blk0 = blockIdx.x, G0 = gridDim.x;
    bf16_t* win_t = (bf16_t*)(p.ws + WS_WIN); bf16_t* wout_t = (bf16_t*)(p.ws + WS_WOUT); bf16_t* hb = (bf16_t*)(p.ws + WS_HB);
    bf16_t* proj = (bf16_t*)(p.ws + WS_PROJ); bf16_t* mix = (bf16_t*)(p.ws + WS_MIX); float* dbuf = (float*)(p.ws + WS_DBUF); bf16_t* scr = (bf16_t*)(p.ws + WS_SCR);
    float* useg = (float*)(p.ws + WS_USEG); float* dseg = (float*)(p.ws + WS_DSEG); unsigned* bar = (unsigned*)(p.ws + WS_CTL);
    float* hf = p.out + O_YP;
    volatile LAS unsigned* bst = (volatile LAS unsigned*)((LAS unsigned char*)lds + 133120);
    if (threadIdx.x < 2) bst[threadIdx.x] = 0u;
    __syncthreads();
    const XcdBarrier xbar = xcd_barrier_post(bar, bst);
#define LAUNDER() int tid, blk = blk0, G = G0; asm volatile("v_mbcnt_lo_u32_b32 %0, -1, 0\n\tv_mbcnt_hi_u32_b32 %0, -1, %0" : "=v"(tid)); tid += wave_s * 64; asm volatile("" : "+v"(tid), "+s"(blk), "+s"(G))
#define GRID_BAR() do { xcd_barrier(xbar); } while (0)
    { LAUNDER(); p0_phase(lds, p, win_t, wout_t, hb, blk, G, tid); }
    cg::this_grid().sync();
    for (int layer = 0; layer < 4; ++layer) {
        const int jl = layer >> 1;
        { LAUNDER(); pg8::Gemm g{hb, win_t + (size_t)layer * N4 * DM, MPR, N4, DM}; pg8::StaticOrder S; S.init(MPR, N4, G, blk); pg8::EpiProjT<true> E{proj, N4};
          pg8::gemm_phase<pg8::EpiProjT<true>, pg8::StaticOrder, false, true>((LAS unsigned char*)lds, g, S, E, tid);
          pg8::mini_gemm((LAS unsigned char*)lds, hb + (size_t)MPR * DM, win_t + (size_t)layer * N4 * DM, proj + (size_t)MPR * N4, N4, N4, blk, G, tid); }
        GRID_BAR();
        if ((layer & 1) == 0) { { LAUNDER(); hgrn_a(lds, p, jl, proj, mix, dbuf, scr, useg, dseg, blk, G, tid); } GRID_BAR(); { LAUNDER(); hgrn_b(lds, p, jl, proj, mix, dbuf, scr, useg, dseg, blk, G, tid); } }
        else { LAUNDER(); attn_phase(lds, p, jl, proj, mix, blk, G, tid); }
        GRID_BAR();
        { LAUNDER(); pg8::Gemm g{mix, wout_t + (size_t)layer * DM * DM, MPR, DM, DM}; pg8::StaticOrder S; S.init(MPR, DM, G, blk); pg8::EpiProjT<false> E{proj, DM};
          pg8::gemm_phase<pg8::EpiProjT<false>, pg8::StaticOrder, false, true>((LAS unsigned char*)lds, g, S, E, tid);
          pg8::mini_gemm((LAS unsigned char*)lds, mix + (size_t)MPR * DM, wout_t + (size_t)layer * DM * DM, proj + (size_t)MPR * DM, DM, DM, blk, G, tid); }
        GRID_BAR();
        { LAUNDER(); ln_phase(p, layer, hf, hb, proj, p.ln_g + layer * DM, p.ln_b + layer * DM, blk, G, tid); }
        if (layer < 3) GRID_BAR();
    }
}

extern "C" void kernel_launch(void* const* d_in, const int* in_sizes, int n_in, void* d_out, int out_size, void* d_ws, size_t ws_size, hipStream_t stream) {
    static int grid = 0;
    if (grid == 0) {
        if (n_in != 12 || ws_size < WS_END || out_size != 99614720) { fprintf(stderr, "kernel_launch: unexpected shapes (n_in %d, out %d, ws %zu)\n", n_in, out_size, ws_size); grid = -1; return; }
        int dev = 0, cus = 0, per_cu = 0;
        (void)hipGetDevice(&dev); (void)hipDeviceGetAttribute(&cus, hipDeviceAttributeMultiprocessorCount, dev);
        if (hipFuncSetAttribute((const void*)fwd_kernel, hipFuncAttributeMaxDynamicSharedMemorySize, LDS_BYTES) != hipSuccess) fprintf(stderr, "kernel_launch: hipFuncSetAttribute failed\n");
        if (hipOccupancyMaxActiveBlocksPerMultiprocessor(&per_cu, (const void*)fwd_kernel, 512, LDS_BYTES) != hipSuccess || per_cu < 1) { fprintf(stderr, "kernel_launch: occupancy query gave %d\n", per_cu); per_cu = 1; }
        (void)hipGetLastError();
        if (cus <= 0) cus = 256;
        grid = cus * per_cu;
    }
    if (grid < 0) return;
    (void)hipMemsetAsync((unsigned char*)d_ws + WS_CTL, 0, 16384, stream);
    Params p{};
    p.xp = (const float*)d_in[0]; p.xs = (const float*)d_in[1]; p.st_in = (const float*)d_in[2]; p.ck_in = (const float*)d_in[3]; p.cv_in = (const float*)d_in[4];
    p.w_in = (const float*)d_in[5]; p.w_out = (const float*)d_in[6]; p.ln_g = (const float*)d_in[7]; p.ln_b = (const float*)d_in[8]; p.lb = (const float*)d_in[9];
    p.ng = (const float*)d_in[10]; p.rb = (const float*)d_in[11]; p.out = (float*)d_out; p.ws = (unsigned char*)d_ws;
    void* args[] = {&p};
    hipError_t e = hipLaunchCooperativeKernel((const void*)fwd_kernel, dim3(grid), dim3(512), args, LDS_BYTES, stream);
    if (e != hipSuccess) fprintf(stderr, "kernel_launch: cooperative launch failed: %s (grid %d)\n", hipGetErrorString(e), grid);
}
```

```cpp
#include <hip/hip_runtime.h>
#include <hip/hip_cooperative_groups.h>
#include <cstdio>
#include <cstdint>
namespace cg = cooperative_groups;

constexpr int DM = 2048, MPR = 32768, MSM = 512, MT = MPR + MSM, N4 = 8192;
constexpr float ALPHA_RES = 1.681792830507429f;
constexpr float ATT_SCALE = 0.08838834764831845f;
constexpr size_t O_YP = 0, O_YS = 67108864, O_STP = 68157440, O_STS = 70254592, O_CKP = 78643200, O_CVP = 87031808, O_CKS = 95420416, O_CVS = 97517568;
constexpr size_t WS_WIN = 0, WS_WOUT = 134217728, WS_HB = 167772160, WS_PROJ = 304087040, WS_MIX = 849346560, WS_DBUF = 985661440, WS_SCR = 989986816, WS_USEG = 1002569728, WS_DSEG = 1019346944, WS_CTL = 1019478016, WS_END = 1019494400;
constexpr int LDS_BYTES = 135168;

namespace pg8 {
#define PG8_LAS __attribute__((address_space(3)))
typedef unsigned short bf16_t;
typedef short bf16x8 __attribute__((ext_vector_type(8)));
typedef float f32x4 __attribute__((ext_vector_type(4)));
typedef unsigned u32x4 __attribute__((ext_vector_type(4)));
constexpr int BM = 256, BK = 64, HALF = 128, HTB = HALF * BK * 2  , STAGE_BYTES = 8 * HTB, NXCD = 8, WGM = 4;

__host__ __device__ __forceinline__ int lds_byte(int r, int c) { const int st = (r >> 4) * 2 + (c >> 5), rr = r & 15, cc = c & 31, ob = rr * 64 + cc * 2; return st * 1024 + (ob ^ (((ob >> 9) & 1) << 5)); }
__host__ __device__ __forceinline__ void stage_rc(int b, int& R, int& C) { const int st = b / 1024, sb = b % 1024, swz = sb ^ (((sb >> 9) & 1) << 5); R = (st >> 1) * 16 + swz / 64; C = (st & 1) * 32 + (swz % 64) / 2; }
__host__ __device__ __forceinline__ int perm32(int rho) { const int n = rho >> 4, i = rho & 15; return 8 * (i >> 2) + 4 * n + (i & 3); }

struct Unit { int pm, pn; };
struct Gemm { const bf16_t* A; const bf16_t* Bt; int M, N, K; };

struct StaticOrder {
    int nM, nN, nwg, G, c;
    __host__ __device__ void init(int M, int N, int G_, int c_) { nM = M / BM; nN = N / BM; nwg = nM * nN; G = G_; c = c_; }
    __host__ __device__ bool next(int i, Unit& u) const {
        const long L = (long)i * G + c; if (L >= nwg) return false;
        int wgid = (int)L; { const int q = nwg / NXCD, r = nwg % NXCD, xcd = wgid % NXCD, off = wgid / NXCD; wgid = (xcd < r ? xcd * (q + 1) : r * (q + 1) + (xcd - r) * q) + off; }
        const int nig = WGM * nN, gid = wgid / nig, fm = gid * WGM, gsz = (nM - fm) < WGM ? (nM - fm) : WGM;
        u.pm = fm + ((wgid % nig) % gsz); u.pn = (wgid % nig) / gsz; return true;
    }
    __device__ __forceinline__ void a_ready(const Unit&) const {}
    __device__ __forceinline__ void done(const Unit&) const {}
};
template <class Epi, class Sched, bool ALIGN_EPI = false, bool SP2 = false>
__device__ __forceinline__ void gemm_phase(PG8_LAS unsigned char* lds, const Gemm g, const Sched& S, const Epi& E, const int tid) {
    const int wid = __builtin_amdgcn_readfirstlane(tid >> 6), lane = tid & 63, wr = wid >> 2, wc = wid & 3, fr = lane & 15, fq = lane >> 4;
    const int K = g.K, nt = K / BK;
    unsigned voffA[2], voffB[2];
#pragma unroll
    for (int i = 0; i < 2; ++i) { int R, C; stage_rc(tid * 16 + i * 8192, R, C); const int Rb = Epi::PERM ? ((R & ~31) + perm32(R & 31)) : R;
        voffA[i] = (unsigned)(R * K + C) * 2u; voffB[i] = (unsigned)(Rb * K + C) * 2u; }
    const size_t kstep = (size_t)(BK * 2);
    const size_t hstep = (size_t)HALF * K * 2;
    const size_t tstep = 2 * hstep;
    const unsigned ldsw = (unsigned)wid * 1024u;
    const int aoff = lds_byte(wr * 64 + fr, fq * 8), boff = lds_byte(wc * 32 + fr, fq * 8);
#define PG8_SA(b, h) (((b) * 2 + (h)) * HTB)
#define PG8_SB(b, h) ((4 + (b) * 2 + (h)) * HTB)
#define PG8_STAGE(bufoff, gbase, voff) do { _Pragma("unroll") for (int _i = 0; _i < 2; ++_i) \
        __builtin_amdgcn_global_load_lds((const unsigned*)((const char*)(gbase) + (voff)[_i]), (PG8_LAS unsigned*)(lds + (bufoff) + ldsw + _i * 8192), 16, 0, 0); } while (0)
#define PG8_LDA(dst, b, h) do { _Pragma("unroll") for (int m = 0; m < 4; ++m) _Pragma("unroll") for (int k = 0; k < 2; ++k) dst[m][k] = *(const PG8_LAS bf16x8*)(lds + PG8_SA(b, h) + aoff + m * 2048 + k * 1024); } while (0)
#define PG8_LDB(dst, b, h) do { _Pragma("unroll") for (int n = 0; n < 2; ++n) _Pragma("unroll") for (int k = 0; k < 2; ++k) dst[n][k] = *(const PG8_LAS bf16x8*)(lds + PG8_SB(b, h) + boff + n * 2048 + k * 1024); } while (0)
#define PG8_MMA(ai, bj, At, Bt) do { __builtin_amdgcn_s_setprio(1); _Pragma("unroll") for (int m = 0; m < 4; ++m) _Pragma("unroll") for (int n = 0; n < 2; ++n) _Pragma("unroll") for (int k = 0; k < 2; ++k) \
        acc[ai][bj][m][n] = __builtin_amdgcn_mfma_f32_16x16x32_bf16(Bt[n][k], At[m][k], acc[ai][bj][m][n], 0, 0, 0); __builtin_amdgcn_s_setprio(0); } while (0)
#define PG8_WAIT_V(n) asm volatile("s_waitcnt vmcnt(" #n ")" ::: "memory")
#define PG8_WAIT_L(n) asm volatile("s_waitcnt lgkmcnt(" #n ")" ::: "memory")
#define PG8_BAR __builtin_amdgcn_s_barrier()
#define PG8_SCHED __builtin_amdgcn_sched_barrier(0)
    Unit cur, nxt; int ui = 0;
    if (!S.next(0, cur)) return;
    f32x4 acc[2][2][4][2];
#pragma unroll
    for (int a = 0; a < 2; ++a)
#pragma unroll
        for (int b = 0; b < 2; ++b)
#pragma unroll
            for (int m = 0; m < 4; ++m)
#pragma unroll
                for (int n = 0; n < 2; ++n) acc[a][b][m][n] = (f32x4){0.f, 0.f, 0.f, 0.f};
    bf16x8 At[4][2], B0[2][2], B1[2][2];
    const char* cA = (const char*)g.A + (size_t)cur.pm * tstep; const char* cB = (const char*)g.Bt + (size_t)cur.pn * tstep;
    S.a_ready(cur);
    if constexpr (SP2) {
        PG8_STAGE(PG8_SB(0, 0), cB, voffB); PG8_STAGE(PG8_SB(0, 1), cB + hstep, voffB); PG8_STAGE(PG8_SA(0, 0), cA, voffA); PG8_STAGE(PG8_SA(0, 1), cA + hstep, voffA);
        if (wr == 1) PG8_BAR;
        PG8_WAIT_V(2); PG8_BAR;
        PG8_STAGE(PG8_SB(1, 0), cB + kstep, voffB); PG8_STAGE(PG8_SA(1, 0), cA + kstep, voffA); PG8_STAGE(PG8_SB(1, 1), cB + hstep + kstep, voffB);
        PG8_WAIT_V(6); PG8_BAR;
    } else {
        PG8_STAGE(PG8_SB(0, 0), cB, voffB); PG8_STAGE(PG8_SA(0, 0), cA, voffA); PG8_STAGE(PG8_SB(0, 1), cB + hstep, voffB); PG8_STAGE(PG8_SA(0, 1), cA + hstep, voffA);
        if (wr == 1) PG8_BAR;
        PG8_WAIT_V(4); PG8_BAR;
        PG8_STAGE(PG8_SB(1, 0), cB + kstep, voffB); PG8_STAGE(PG8_SA(1, 0), cA + kstep, voffA); PG8_STAGE(PG8_SB(1, 1), cB + hstep + kstep, voffB);
        PG8_WAIT_V(6); PG8_BAR;
    }
    for (;;) {
        const bool has_next = S.next(ui + 1, nxt);
        const char* nA = has_next ? (const char*)g.A + (size_t)nxt.pm * tstep : cA; const char* nB = has_next ? (const char*)g.Bt + (size_t)nxt.pn * tstep : cB;
        for (int t = 0; t < nt; t += 2) {
            const bool last = (t == nt - 2);
            const char* a1 = cA + (size_t)(t + 1) * kstep;
            const char* a2 = last ? nA : cA + (size_t)(t + 2) * kstep; const char* b2 = last ? nB : cB + (size_t)(t + 2) * kstep;
            const char* a3 = a2 + kstep; const char* b3 = b2 + kstep;
            if (last && has_next) S.a_ready(nxt);
            if constexpr (SP2) {
            PG8_LDB(B0, 0, 0); PG8_LDB(B1, 0, 1); PG8_SCHED; PG8_LDA(At, 0, 0); PG8_STAGE(PG8_SA(1, 1), a1 + hstep, voffA);
            PG8_WAIT_V(8); PG8_WAIT_L(0); PG8_BAR; PG8_MMA(0, 0, At, B0); PG8_MMA(0, 1, At, B1); PG8_BAR; PG8_SCHED;
            PG8_LDA(At, 0, 1); PG8_STAGE(PG8_SB(0, 0), b2, voffB); PG8_STAGE(PG8_SB(0, 1), b2 + hstep, voffB); PG8_STAGE(PG8_SA(0, 0), a2, voffA);
            PG8_WAIT_V(8); PG8_WAIT_L(0); PG8_BAR; PG8_MMA(1, 0, At, B0); PG8_MMA(1, 1, At, B1); PG8_BAR; PG8_SCHED;
            PG8_LDB(B0, 1, 0); PG8_LDB(B1, 1, 1); PG8_SCHED; PG8_LDA(At, 1, 0); PG8_STAGE(PG8_SA(0, 1), a2 + hstep, voffA);
            PG8_WAIT_V(8); PG8_WAIT_L(0); PG8_BAR; PG8_MMA(0, 0, At, B0); PG8_MMA(0, 1, At, B1); PG8_BAR; PG8_SCHED;
            PG8_LDA(At, 1, 1); PG8_STAGE(PG8_SB(1, 0), b3, voffB); PG8_STAGE(PG8_SB(1, 1), b3 + hstep, voffB); PG8_STAGE(PG8_SA(1, 0), a3, voffA);
            PG8_WAIT_V(8); PG8_WAIT_L(0); PG8_BAR; PG8_MMA(1, 0, At, B0); PG8_MMA(1, 1, At, B1); PG8_BAR; PG8_SCHED;
            } else {
            PG8_LDB(B0, 0, 0); PG8_SCHED; PG8_LDA(At, 0, 0); PG8_STAGE(PG8_SA(1, 1), a1 + hstep, voffA);
            PG8_WAIT_L(8); PG8_BAR; PG8_WAIT_L(0); PG8_MMA(0, 0, At, B0); PG8_BAR; PG8_SCHED;
            PG8_LDB(B1, 0, 1); PG8_STAGE(PG8_SB(0, 0), b2, voffB);
            PG8_BAR; PG8_WAIT_L(0); PG8_MMA(0, 1, At, B1); PG8_BAR;
            PG8_LDA(At, 0, 1); PG8_STAGE(PG8_SA(0, 0), a2, voffA);
            PG8_BAR; PG8_WAIT_L(0); PG8_MMA(1, 0, At, B0); PG8_BAR; PG8_SCHED;
            PG8_STAGE(PG8_SB(0, 1), b2 + hstep, voffB);
            PG8_WAIT_V(6); PG8_BAR; PG8_MMA(1, 1, At, B1); PG8_BAR;
            PG8_LDB(B0, 1, 0); PG8_SCHED; PG8_LDA(At, 1, 0); PG8_STAGE(PG8_SA(0, 1), a2 + hstep, voffA);
            PG8_WAIT_L(8); PG8_BAR; PG8_WAIT_L(0); PG8_MMA(0, 0, At, B0); PG8_BAR; PG8_SCHED;
            PG8_LDB(B1, 1, 1); PG8_STAGE(PG8_SB(1, 0), b3, voffB);
            PG8_BAR; PG8_WAIT_L(0); PG8_MMA(0, 1, At, B1); PG8_BAR;
            PG8_LDA(At, 1, 1); PG8_STAGE(PG8_SA(1, 0), a3, voffA);
            PG8_BAR; PG8_WAIT_L(0); PG8_MMA(1, 0, At, B0); PG8_BAR; PG8_SCHED;
            PG8_STAGE(PG8_SB(1, 1), b3 + hstep, voffB);
            PG8_WAIT_V(6); PG8_BAR; PG8_MMA(1, 1, At, B1); PG8_BAR;
            }
        }
        if constexpr (ALIGN_EPI) { if (wr == 0) PG8_BAR; }
        if constexpr (!Epi::AFTER_DRAIN) { E(acc, cur, wr, wc, fr, fq); S.done(cur); }
        if (!has_next) break;
#pragma unroll
        for (int a = 0; a < 2; ++a)
#pragma unroll
            for (int b = 0; b < 2; ++b)
#pragma unroll
                for (int m = 0; m < 4; ++m)
#pragma unroll
                    for (int n = 0; n < 2; ++n) acc[a][b][m][n] = (f32x4){0.f, 0.f, 0.f, 0.f};
        cur = nxt; cA = nA; cB = nB; ++ui;
        if constexpr (ALIGN_EPI) { if (wr == 1) PG8_BAR; }
    }
    PG8_WAIT_V(0);
    if constexpr (!ALIGN_EPI) { if (wr == 0) PG8_BAR; }
    PG8_BAR;
    if constexpr (Epi::AFTER_DRAIN) { E.fused(acc, cur, wr, wc, fr, fq, lds, wid, lane); S.done(cur); }
#undef PG8_SA
#undef PG8_SB
#undef PG8_STAGE
#undef PG8_LDA
#undef PG8_LDB
#undef PG8_MMA
#undef PG8_WAIT_V
#undef PG8_WAIT_L
#undef PG8_BAR
#undef PG8_SCHED
}
}
using pg8::bf16_t; using pg8::bf16x8; using pg8::f32x4; using pg8::u32x4;
typedef short bf16x4 __attribute__((ext_vector_type(4)));
typedef unsigned u32x2 __attribute__((ext_vector_type(2)));
typedef __bf16 hbf2 __attribute__((ext_vector_type(2)));
typedef float f32x2 __attribute__((ext_vector_type(2)));
#define LAS __attribute__((address_space(3)))
#define MFMA16(a, b, c) __builtin_amdgcn_mfma_f32_16x16x32_bf16((a), (b), (c), 0, 0, 0)

__device__ __forceinline__ unsigned pk2(float lo, float hi) { f32x2 v = {lo, hi}; hbf2 b = __builtin_convertvector(v, hbf2); return __builtin_bit_cast(unsigned, b); }
__device__ __forceinline__ bf16_t f2bf(float f) { return (bf16_t)(pk2(f, 0.f) & 0xffffu); }
__device__ __forceinline__ float bf2f(short b) { return __uint_as_float(((unsigned)(unsigned short)b) << 16); }
__device__ __forceinline__ bf16x8 pack8(f32x4 a, f32x4 b) { u32x4 w = {pk2(a[0], a[1]), pk2(a[2], a[3]), pk2(b[0], b[1]), pk2(b[2], b[3])}; return __builtin_bit_cast(bf16x8, w); }
__device__ __forceinline__ u32x2 pack4(f32x4 a) { u32x2 w = {pk2(a[0], a[1]), pk2(a[2], a[3])}; return w; }
__device__ __forceinline__ bf16x8 cat8(bf16x4 lo, bf16x4 hi) { return __builtin_shufflevector(lo, hi, 0, 1, 2, 3, 4, 5, 6, 7); }
__device__ __forceinline__ float fexp(float x) { return __builtin_amdgcn_exp2f(x * 1.4426950408889634f); }
__device__ __forceinline__ float flog(float x) { return __builtin_amdgcn_logf(x) * 0.6931471805599453f; }
__device__ __forceinline__ float silu_f(float x) { return x * __builtin_amdgcn_rcpf(1.f + fexp(-x)); }
__device__ __forceinline__ float wave_sum(float v) {
#pragma unroll
    for (int o = 1; o < 64; o <<= 1) v += __shfl_xor(v, o);
    return v;
}

struct Params {
    const float* xp; const float* xs; const float* st_in; const float* ck_in; const float* cv_in;
    const float* w_in; const float* w_out; const float* ln_g; const float* ln_b; const float* lb; const float* ng; const float* rb;
    float* out; unsigned char* ws;
};

namespace pg8 {
template <bool NT> struct EpiProjT {
    static constexpr bool PERM = true, AFTER_DRAIN = false;
    bf16_t* O; int ldc;
    __device__ __forceinline__ void operator()(const f32x4 (&acc)[2][2][4][2], const Unit& u, int wr, int wc, int fr, int fq) const {
        const int row0 = u.pm * BM + wr * 64 + fr, col0 = u.pn * BM + wc * 32 + 8 * fq;
#pragma unroll
        for (int ai = 0; ai < 2; ++ai)
#pragma unroll
            for (int m = 0; m < 4; ++m) { bf16_t* rowp = O + (size_t)(row0 + ai * HALF + m * 16) * ldc + col0;
#pragma unroll
                for (int bj = 0; bj < 2; ++bj) { const f32x4 v0 = acc[ai][bj][m][0], v1 = acc[ai][bj][m][1];
                    u32x4 w; w.x = pk2(v0[0], v0[1]); w.y = pk2(v0[2], v0[3]); w.z = pk2(v1[0], v1[1]); w.w = pk2(v1[2], v1[3]);
                    if constexpr (NT) __builtin_nontemporal_store(w, (u32x4*)(rowp + bj * HALF)); else *(u32x4*)(rowp + bj * HALF) = w; } }
    }
};
struct EpiRes {
    static constexpr bool PERM = false, AFTER_DRAIN = false;
    const float* xp; const float* xs; float* hf; int layer;
    __device__ __forceinline__ void operator()(const f32x4 (&acc)[2][2][4][2], const Unit& u, int wr, int wc, int fr, int fq) const {
        const int row0 = u.pm * BM + wr * 64 + fr, col0 = u.pn * BM + wc * 32 + 4 * fq;
#pragma unroll
        for (int ai = 0; ai < 2; ++ai)
#pragma unroll
            for (int m = 0; m < 4; ++m) { const int row = row0 + ai * HALF + m * 16;
                const float* res = (layer == 0) ? (row < MPR ? xp + (size_t)row * DM : xs + (size_t)(row - MPR) * DM) : hf + (size_t)row * DM;
                float* outp = hf + (size_t)row * DM;
#pragma unroll
                for (int bj = 0; bj < 2; ++bj)
#pragma unroll
                    for (int n = 0; n < 2; ++n) { const int c = col0 + bj * HALF + n * 16; const f32x4 r = *(const f32x4*)(res + c);
                        *(f32x4*)(outp + c) = r * ALPHA_RES + acc[ai][bj][m][n]; } }
    }
};
}
namespace pg8 {
__device__ __forceinline__ void mini_gemm(PG8_LAS unsigned char* lds, const bf16_t* A, const bf16_t* Bt, bf16_t* O, int ldc, int N, int blk, int G, const int tid) {
    const int wid = __builtin_amdgcn_readfirstlane(tid >> 6), lane = tid & 63, wr = wid >> 2, wc = wid & 3, fr = lane & 15, fq = lane >> 4;
    constexpr int K = 2048, NKT = K / BK;
    unsigned voffA[2], voffB[2];
#pragma unroll
    for (int i = 0; i < 2; ++i) { int R, C; stage_rc(tid * 16 + i * 8192, R, C); const int Rb = (R & ~31) + perm32(R & 31);
        voffA[i] = (unsigned)(R * K + C) * 2u; voffB[i] = (unsigned)(Rb * K + C) * 2u; }
    const unsigned ldsw = (unsigned)wid * 1024u;
    const int aoff = lds_byte(wr * 64 + fr, fq * 8), boff = lds_byte(wc * 32 + fr, fq * 8);
#define MG_STAGE(s, kt) do { _Pragma("unroll") for (int _i = 0; _i < 2; ++_i) { \
        __builtin_amdgcn_global_load_lds((const unsigned*)(cA + (size_t)(kt) * (BK * 2) + voffA[_i]), (PG8_LAS unsigned*)(lds + (s) * 32768 + ldsw + _i * 8192), 16, 0, 0); \
        __builtin_amdgcn_global_load_lds((const unsigned*)(cB + (size_t)(kt) * (BK * 2) + voffB[_i]), (PG8_LAS unsigned*)(lds + (s) * 32768 + 16384 + ldsw + _i * 8192), 16, 0, 0); } } while (0)
#define MG_COMPUTE(s) do { bf16x8 At[4][2], Bf[2][2]; \
        _Pragma("unroll") for (int n = 0; n < 2; ++n) _Pragma("unroll") for (int k = 0; k < 2; ++k) Bf[n][k] = *(const PG8_LAS bf16x8*)(lds + (s) * 32768 + 16384 + boff + n * 2048 + k * 1024); \
        _Pragma("unroll") for (int m = 0; m < 4; ++m) _Pragma("unroll") for (int k = 0; k < 2; ++k) At[m][k] = *(const PG8_LAS bf16x8*)(lds + (s) * 32768 + aoff + m * 2048 + k * 1024); \
        asm volatile("s_waitcnt lgkmcnt(0)" ::: "memory"); __builtin_amdgcn_sched_barrier(0); \
        _Pragma("unroll") for (int m = 0; m < 4; ++m) _Pragma("unroll") for (int n = 0; n < 2; ++n) _Pragma("unroll") for (int k = 0; k < 2; ++k) \
            acc[m][n] = __builtin_amdgcn_mfma_f32_16x16x32_bf16(Bf[n][k], At[m][k], acc[m][n], 0, 0, 0); \
        __builtin_amdgcn_sched_barrier(0); } while (0)
    const int nunits = 4 * (N / 128);
    for (int u = blk; u < nunits; u += G) {
        const int tm = u & 3, tn = u >> 2;
        const char* cA = (const char*)(A + (size_t)tm * 128 * K); const char* cB = (const char*)(Bt + (size_t)tn * 128 * K);
        f32x4 acc[4][2];
#pragma unroll
        for (int m = 0; m < 4; ++m)
#pragma unroll
            for (int n = 0; n < 2; ++n) acc[m][n] = (f32x4){0.f, 0.f, 0.f, 0.f};
        MG_STAGE(0, 0); MG_STAGE(1, 1); MG_STAGE(2, 2);
        for (int kt = 0; kt < NKT - 3; ++kt) {
            asm volatile("s_waitcnt vmcnt(8)" ::: "memory"); __builtin_amdgcn_s_barrier(); __builtin_amdgcn_sched_barrier(0);
            MG_STAGE((kt + 3) & 3, kt + 3);
            MG_COMPUTE(kt & 3);
        }
        asm volatile("s_waitcnt vmcnt(8)" ::: "memory"); __builtin_amdgcn_s_barrier(); __builtin_amdgcn_sched_barrier(0); MG_COMPUTE((NKT - 3) & 3);
        asm volatile("s_waitcnt vmcnt(4)" ::: "memory"); __builtin_amdgcn_s_barrier(); __builtin_amdgcn_sched_barrier(0); MG_COMPUTE((NKT - 2) & 3);
        asm volatile("s_waitcnt vmcnt(0)" ::: "memory"); __builtin_amdgcn_s_barrier(); __builtin_amdgcn_sched_barrier(0); MG_COMPUTE((NKT - 1) & 3);
        const int row0 = tm * 128 + wr * 64 + fr, col0 = tn * 128 + wc * 32 + 8 * fq;
#pragma unroll
        for (int m = 0; m < 4; ++m) { const f32x4 v0 = acc[m][0], v1 = acc[m][1]; u32x4 w; w.x = pk2(v0[0], v0[1]); w.y = pk2(v0[2], v0[3]); w.z = pk2(v1[0], v1[1]); w.w = pk2(v1[2], v1[3]);
            *(u32x4*)(O + (size_t)(row0 + m * 16) * ldc + col0) = w; }
        __builtin_amdgcn_s_barrier();
    }
    asm volatile("s_waitcnt vmcnt(0)" ::: "memory");
#undef MG_STAGE
#undef MG_COMPUTE
}
}

template <bool ntst> __device__ __forceinline__ void p0_transpose_item(const float* W, int K, int N, bf16_t* WT, LAS float* scr, int item, int lane) {
    const int nblk = N / 32, kb = item / nblk, nb = item % nblk, k0 = 64 * kb, n0 = 32 * nb;
    float r[32];
#pragma unroll
    for (int i = 0; i < 32; ++i) { const int kk = 2 * i + (lane >> 5); r[i] = __builtin_nontemporal_load(W + (size_t)(k0 + kk) * N + n0 + (lane & 31)); }
#pragma unroll
    for (int i = 0; i < 32; ++i) { const int kk = 2 * i + (lane >> 5); scr[kk * 33 + (lane & 31)] = r[i]; }
    asm volatile("s_waitcnt lgkmcnt(0)" ::: "memory");
    const int c = lane & 7;
#pragma unroll
    for (int j = 0; j < 4; ++j) { const int n = (lane >> 3) + 8 * j; const LAS float* s = scr + (8 * c) * 33 + n;
        u32x4 o; o.x = pk2(s[0 * 33], s[1 * 33]); o.y = pk2(s[2 * 33], s[3 * 33]); o.z = pk2(s[4 * 33], s[5 * 33]); o.w = pk2(s[6 * 33], s[7 * 33]);
        if (ntst) __builtin_nontemporal_store(o, (u32x4*)(WT + (size_t)(n0 + n) * K + k0 + 8 * c)); else *(u32x4*)(WT + (size_t)(n0 + n) * K + k0 + 8 * c) = o; }
    asm volatile("s_waitcnt lgkmcnt(0)" ::: "memory");
}
__device__ __forceinline__ void p0_phase(unsigned char* lds, const Params& p, bf16_t* win_t, bf16_t* wout_t, bf16_t* hb, int blk, int G, int tid) {
    const int lane = tid & 63, wave = tid >> 6;
    { const size_t ngrp = (size_t)MT * DM / 8, npg = (size_t)MPR * DM / 8, stride = (size_t)G * 512;
      for (size_t i0 = (size_t)blk * 512 + tid; i0 < ngrp; i0 += 4 * stride) {
          f32x4 a[4], b[4];
#pragma unroll
          for (int q = 0; q < 4; ++q) { const size_t i = i0 + q * stride; if (i < ngrp) { const float* s = (i < npg) ? p.xp + i * 8 : p.xs + (i - npg) * 8; a[q] = __builtin_nontemporal_load((const f32x4*)s); b[q] = __builtin_nontemporal_load((const f32x4*)(s + 4)); } }
#pragma unroll
          for (int q = 0; q < 4; ++q) { const size_t i = i0 + q * stride; if (i < ngrp) *(bf16x8*)(hb + i * 8) = pack8(a[q], b[q]); }
      } }
    LAS float* scr = (LAS float*)((LAS unsigned char*)lds + wave * 16384);
    const int gw = blk * 8 + wave, NGW = G * 8;
    for (int it = gw; it < 40960; it += NGW) {
        if (it < 8192) { p0_transpose_item<false>(p.w_in, DM, N4, win_t, scr, it, lane); }
        else if (it < 32768) { const int l = it >> 13, r = it & 8191; p0_transpose_item<true>(p.w_in + (size_t)l * DM * N4, DM, N4, win_t + (size_t)l * N4 * DM, scr, r, lane); }
        else { const int i2 = it - 32768, l = i2 >> 11, r = i2 & 2047; p0_transpose_item<true>(p.w_out + (size_t)l * DM * DM, DM, DM, wout_t + (size_t)l * DM * DM, scr, r, lane); }
    }
}

__device__ __forceinline__ void ln_phase(const Params& p, int layer, float* hf, bf16_t* hb, const bf16_t* yb, const float* g, const float* b, int blk, int G, int tid) {
    const int lane = tid & 63, wave = tid >> 6;
    f32x4 v[8]; u32x2 y[8];
#define UNPK4(D, W) do { D[0] = __uint_as_float((W)[0] << 16); D[1] = __uint_as_float((W)[0] & 0xffff0000u); D[2] = __uint_as_float((W)[1] << 16); D[3] = __uint_as_float((W)[1] & 0xffff0000u); } while (0)
#define LN_LOAD(V, Y, m_) do { const int mm_ = (m_); const bf16_t* yr_ = yb + (size_t)mm_ * DM + lane * 4; \
        if (layer == 0) { const float* res_ = (mm_ < MPR ? p.xp + (size_t)mm_ * DM : p.xs + (size_t)(mm_ - MPR) * DM) + lane * 4; \
            _Pragma("unroll") for (int j = 0; j < 8; ++j) V[j] = __builtin_nontemporal_load((const f32x4*)(res_ + j * 256)); } \
        else { const bf16_t* res_ = hb + (size_t)mm_ * DM + lane * 4; \
            _Pragma("unroll") for (int j = 0; j < 8; ++j) { const u32x2 w_ = __builtin_nontemporal_load((const u32x2*)(res_ + j * 256)); UNPK4(V[j], w_); } } \
        _Pragma("unroll") for (int j = 0; j < 8; ++j) Y[j] = __builtin_nontemporal_load((const u32x2*)(yr_ + j * 256)); } while (0)
    f32x4 gam[8], bet[8];
#pragma unroll
    for (int j = 0; j < 8; ++j) { gam[j] = *(const f32x4*)(g + j * 256 + lane * 4); bet[j] = *(const f32x4*)(b + j * 256 + lane * 4); }
    int m = blk * 8 + wave;
    if (m < MT) LN_LOAD(v, y, m);
    while (m < MT) {
        const int mn = m + G * 8;
        f32x4 v2[8]; u32x2 y2[8];
#pragma unroll
        for (int j = 0; j < 8; ++j) { v2[j] = (f32x4){0.f, 0.f, 0.f, 0.f}; y2[j] = (u32x2){0u, 0u}; }
        if (mn < MT) LN_LOAD(v2, y2, mn);
        float s = 0.f;
#pragma unroll
        for (int j = 0; j < 8; ++j) { f32x4 yy; UNPK4(yy, y[j]); v[j] = v[j] * ALPHA_RES + yy; s += (v[j][0] + v[j][1]) + (v[j][2] + v[j][3]); }
        const float mean = wave_sum(s) * (1.f / DM); float s2 = 0.f;
#pragma unroll
        for (int j = 0; j < 8; ++j) { v[j] = v[j] - mean; s2 += (v[j][0] * v[j][0] + v[j][1] * v[j][1]) + (v[j][2] * v[j][2] + v[j][3] * v[j][3]); }
        const float rstd = rsqrtf(wave_sum(s2) * (1.f / DM) + 1e-5f);
        if (layer == 3) { float* row = hf + (size_t)m * DM + lane * 4;
#pragma unroll
            for (int j = 0; j < 8; ++j) { const f32x4 gg = gam[j], bb = bet[j]; __builtin_nontemporal_store(v[j] * rstd * gg + bb, (f32x4*)(row + j * 256)); } }
        else { bf16_t* orow = hb + (size_t)m * DM + lane * 4;
#pragma unroll
            for (int j = 0; j < 8; ++j) { const f32x4 gg = gam[j], bb = bet[j]; *(u32x2*)(orow + j * 256) = pack4(v[j] * rstd * gg + bb); } }
#pragma unroll
        for (int j = 0; j < 8; ++j) { v[j] = v2[j]; y[j] = y2[j]; }
        m = mn;
    }
#undef LN_LOAD
#undef UNPK4
}

__device__ __forceinline__ bf16x8 attn_ld8(bool samp, const bf16_t* proj, const float* cache, int jl, int b, int h, int t, int row, int col, int coloff) {
    bf16x8 r = {0, 0, 0, 0, 0, 0, 0, 0};
    if (!samp) return *(const bf16x8*)(proj + (size_t)(b * 8192 + t * 64 + row) * N4 + coloff + h * 128 + col);
    if (t < 8) { const float* s = cache + (size_t)((jl * 16 + b) * 512 + t * 64 + row) * DM + h * 128 + col; return pack8(*(const f32x4*)s, *(const f32x4*)(s + 4)); }
    if (row < 32) r = *(const bf16x8*)(proj + (size_t)(MPR + b * 32 + row) * N4 + coloff + h * 128 + col);
    return r;
}
__device__ __forceinline__ void attn_phase(unsigned char* lds, const Params& p, int jl, const bf16_t* proj, bf16_t* mix, int blk, int G, int tid) {
    bf16_t* KS = (bf16_t*)lds;
    bf16_t* VT = (bf16_t*)(lds + 34816);
    float* BIAS = (float*)(lds + 34816 + 36864);
    const int lane = tid & 63, w = tid >> 6, fr = lane & 15, fq = lane >> 4;
    for (int gi = blk * 512 + tid; gi < 2560 * 2 * 256; gi += G * 512) {
        const int c8 = gi & 255, kv = (gi >> 8) & 1, r = gi >> 9;
        size_t srow, dst;
        if (r < 2048) { const int b = r >> 9, tp = r & 511; srow = (size_t)b * 8192 + 7680 + tp; dst = (kv ? O_CVP : O_CKP) + ((size_t)(jl * 4 + b) * 512 + tp) * DM + c8 * 8; }
        else { const int rs = r - 2048; srow = (size_t)MPR + rs; dst = (kv ? O_CVS : O_CKS) + ((size_t)jl * 512 + rs) * DM + c8 * 8; }
        const bf16x8 x = *(const bf16x8*)(proj + srow * N4 + 2048 + kv * 2048 + c8 * 8);
        f32x4 a, b2;
#pragma unroll
        for (int j = 0; j < 4; ++j) { a[j] = bf2f(x[j]); b2[j] = bf2f(x[4 + j]); }
        *(f32x4*)(p.out + dst) = a; *(f32x4*)(p.out + dst + 4) = b2;
    }
    const float NEG_INF = -__builtin_inff();
    constexpr float SC2 = ATT_SCALE * 1.4426950408889634f;
    for (int u = blk; u < 256 + 2048; u += G) {
        const bool samp = u < 256;
        int b, h, qc4 = 0;
        if (samp) { b = u >> 4; h = u & 15; } else { const int v = u - 256; qc4 = v & 31; h = (v >> 5) & 15; b = v >> 9; }
        const int qrow0 = samp ? MPR + b * 32 : b * 8192 + qc4 * 256;
        const int t_lo = samp ? 0 : (4 * qc4 - 8 > 0 ? 4 * qc4 - 8 : 0), t_hi = samp ? 8 : 4 * qc4 + 3;
        const int cq = 4 * qc4 + (w >> 1);
        const int w_lo = samp ? 0 : cq - 8, w_hi = samp ? (w < 1 ? 8 : -1) : cq;
        const int qpos0 = samp ? 512 + fr : qc4 * 256 + w * 32 + fr;
        const float* kcache = p.ck_in; const float* vcache = p.cv_in;
        const bf16_t* pkbase = proj + (size_t)b * 8192 * N4 + 2048 + h * 128;
        for (int r_ = tid; r_ < 639; r_ += 512) { const int rel_ = 575 - r_; BIAS[r_] = p.rb[(jl * 16 + h) * 320 + (rel_ > 256 ? 256 : rel_) + 63] * 1.4426950408889634f; }
        const int qr = (samp && w >= 1) ? qrow0 + fr : qrow0 + w * 32 + fr;
        bf16x8 qf[2][4];
#pragma unroll
        for (int qt = 0; qt < 2; ++qt)
#pragma unroll
            for (int k4 = 0; k4 < 4; ++k4) qf[qt][k4] = *(const bf16x8*)(proj + (size_t)(qr + qt * 16) * N4 + h * 128 + k4 * 32 + fq * 8);
        f32x4 o[2][8];
#pragma unroll
        for (int qt = 0; qt < 2; ++qt)
#pragma unroll
            for (int dt = 0; dt < 8; ++dt) o[qt][dt] = (f32x4){0.f, 0.f, 0.f, 0.f};
        float m_run[2] = {-1e30f, -1e30f}, l_run[2] = {0.f, 0.f};
        bf16x8 kc0, kc1, vc0, vc1;
#define ATT_LOADT(t) do { int tl_ = tid; asm volatile("" : "+v"(tl_)); const int krow_ = tl_ >> 4, kcc_ = tl_ & 15, vkey_ = tl_ & 63, vdc_ = tl_ >> 6; \
        if (!samp) { const bf16_t* kt_ = pkbase + (size_t)(t) * (64 * N4); const unsigned ko_ = (unsigned)(krow_ * N4 + kcc_ * 8), vo_ = (unsigned)(vkey_ * N4 + 2048 + vdc_ * 8); \
            kc0 = *(const bf16x8*)(kt_ + ko_); kc1 = *(const bf16x8*)(kt_ + (ko_ + 32u * N4)); vc0 = *(const bf16x8*)(kt_ + vo_); vc1 = *(const bf16x8*)(kt_ + (vo_ + 64u)); } \
        else { kc0 = attn_ld8(samp, proj, kcache, jl, b, h, (t), krow_, kcc_ * 8, 2048); kc1 = attn_ld8(samp, proj, kcache, jl, b, h, (t), krow_ + 32, kcc_ * 8, 2048); \
            vc0 = attn_ld8(samp, proj, vcache, jl, b, h, (t), vkey_, vdc_ * 8, 4096); vc1 = attn_ld8(samp, proj, vcache, jl, b, h, (t), vkey_, (vdc_ + 8) * 8, 4096); } } while (0)
#define ATT_WRITET(bf) do { int tl_ = tid; asm volatile("" : "+v"(tl_)); const int krow_ = tl_ >> 4, kcc_ = tl_ & 15, vkey_ = tl_ & 63, vdc_ = tl_ >> 6; \
        bf16_t* ks_ = KS + (bf) * (64 * 136) + krow_ * 136 + kcc_ * 8; bf16_t* vt_ = VT + (bf) * (128 * 72) + vdc_ * 8 * 72 + vkey_; \
        *(bf16x8*)ks_ = kc0; *(bf16x8*)(ks_ + 32 * 136) = kc1; \
        _Pragma("unroll") for (int e = 0; e < 8; ++e) { vt_[e * 72] = (bf16_t)vc0[e]; vt_[(64 + e) * 72] = (bf16_t)vc1[e]; } } while (0)
        ATT_LOADT(t_lo);
        ATT_WRITET(0);
        __syncthreads();
        const int nt = t_hi - t_lo + 1;
        for (int i = 0; i < nt; ++i) {
            const int t = t_lo + i, buf = i & 1;
            if (i + 1 < nt) ATT_LOADT(t + 1);
            if (t >= w_lo && t <= w_hi) {
                const bf16_t* ks = KS + buf * (64 * 136); const bf16_t* vt = VT + buf * (128 * 72);
                const int nvk = (samp && t == 8) ? 32 : 64;
                f32x4 s[2][4];
#pragma unroll
                for (int qt = 0; qt < 2; ++qt)
#pragma unroll
                    for (int kt = 0; kt < 4; ++kt) s[qt][kt] = (f32x4){0.f, 0.f, 0.f, 0.f};
#pragma unroll
                for (int kh2 = 0; kh2 < 2; ++kh2) { bf16x8 kf[2][4];
#pragma unroll
                    for (int kt = 0; kt < 2; ++kt)
#pragma unroll
                        for (int k4 = 0; k4 < 4; ++k4) kf[kt][k4] = *(const bf16x8*)(ks + ((kh2 * 2 + kt) * 16 + fr) * 136 + k4 * 32 + fq * 8);
                    __builtin_amdgcn_sched_barrier(0);
#pragma unroll
                    for (int k4 = 0; k4 < 4; ++k4)
#pragma unroll
                        for (int kt = 0; kt < 2; ++kt)
#pragma unroll
                            for (int qt = 0; qt < 2; ++qt) s[qt][kh2 * 2 + kt] = MFMA16(kf[kt][k4], qf[qt][k4], s[qt][kh2 * 2 + kt]);
                    __builtin_amdgcn_sched_barrier(0); }
                bf16x8 vf[4][2][2];
#define ATT_VLOAD(g4) do { _Pragma("unroll") for (int d = 0; d < 2; ++d) _Pragma("unroll") for (int k2 = 0; k2 < 2; ++k2) { const bf16_t* vp = vt + (((g4) * 2 + d) * 16 + fr) * 72 + k2 * 32 + fq * 4; \
                    vf[g4][d][k2] = cat8(*(const bf16x4*)vp, *(const bf16x4*)(vp + 16)); } } while (0)
#define ATT_VMMA(g4) do { _Pragma("unroll") for (int k2 = 0; k2 < 2; ++k2) _Pragma("unroll") for (int d = 0; d < 2; ++d) _Pragma("unroll") for (int qt = 0; qt < 2; ++qt) \
                    o[qt][(g4) * 2 + d] = MFMA16(vf[g4][d][k2], pb[qt][k2], o[qt][(g4) * 2 + d]); } while (0)
                ATT_VLOAD(0);
                __builtin_amdgcn_sched_barrier(0);
                bf16x8 pb[2][2];
#pragma unroll
                for (int qt = 0; qt < 2; ++qt) {
                    const float* bp = BIAS + (575 - (qpos0 + qt * 16 - t * 64 - fq * 4));
#pragma unroll
                    for (int kt = 0; kt < 4; ++kt) { const f32x4 bv = {bp[kt * 16], bp[kt * 16 + 1], bp[kt * 16 + 2], bp[kt * 16 + 3]}; s[qt][kt] = s[qt][kt] * SC2 + bv; }
                    if (nvk < 64) {
#pragma unroll
                        for (int kt = 0; kt < 4; ++kt)
#pragma unroll
                            for (int j = 0; j < 4; ++j) if (kt * 16 + fq * 4 + j >= nvk) s[qt][kt][j] = NEG_INF; }
                    float mx;
                    { const f32x4 m01 = __builtin_elementwise_max(s[qt][0], s[qt][1]), m23 = __builtin_elementwise_max(s[qt][2], s[qt][3]), m4 = __builtin_elementwise_max(m01, m23);
                      mx = fmaxf(fmaxf(m4[0], m4[1]), fmaxf(m4[2], m4[3])); }
                    mx = fmaxf(mx, __shfl_xor(mx, 16)); mx = fmaxf(mx, __shfl_xor(mx, 32));
                    const float m_new = fmaxf(m_run[qt], mx), alpha = __builtin_amdgcn_exp2f(m_run[qt] - m_new);
#pragma unroll
                    for (int kt = 0; kt < 4; ++kt) { s[qt][kt] = s[qt][kt] - m_new;
#pragma unroll
                        for (int j = 0; j < 4; ++j) s[qt][kt][j] = __builtin_amdgcn_exp2f(s[qt][kt][j]); }
                    const f32x4 sv4 = (s[qt][0] + s[qt][1]) + (s[qt][2] + s[qt][3]);
                    const float ps = (sv4[0] + sv4[1]) + (sv4[2] + sv4[3]);
                    l_run[qt] = l_run[qt] * alpha + ps; m_run[qt] = m_new;
                    if (__any(alpha != 1.f)) {
#pragma unroll
                        for (int dt = 0; dt < 8; ++dt) o[qt][dt] = o[qt][dt] * alpha; }
                    pb[qt][0] = pack8(s[qt][0], s[qt][1]); pb[qt][1] = pack8(s[qt][2], s[qt][3]);
                }
                __builtin_amdgcn_sched_barrier(0);
                ATT_VLOAD(1); ATT_VMMA(0);
                __builtin_amdgcn_sched_barrier(0);
                ATT_VLOAD(2); ATT_VMMA(1);
                __builtin_amdgcn_sched_barrier(0);
                ATT_VLOAD(3); ATT_VMMA(2);
                __builtin_amdgcn_sched_barrier(0);
                ATT_VMMA(3);
#undef ATT_VLOAD
#undef ATT_VMMA
            }
            if (i + 1 < nt) ATT_WRITET(buf ^ 1);
            __syncthreads();
        }
#undef ATT_LOADT
#undef ATT_WRITET
#pragma unroll
        for (int qt = 0; qt < 2; ++qt) {
            float l = l_run[qt]; l += __shfl_xor(l, 16); l += __shfl_xor(l, 32);
            if (!samp || w < 1) {
                const float inv = 1.f / l; const int row = qrow0 + (samp ? 0 : w * 32) + qt * 16 + fr;
                const bf16_t* gp = proj + (size_t)row * N4 + 6144 + h * 128 + fq * 4; bf16_t* mp = mix + (size_t)row * DM + h * 128 + fq * 4;
#pragma unroll
                for (int dt = 0; dt < 8; ++dt) { const bf16x4 gv = *(const bf16x4*)(gp + dt * 16); f32x4 ov;
#pragma unroll
                    for (int j = 0; j < 4; ++j) { const float gg = bf2f(gv[j]); ov[j] = o[qt][dt][j] * inv * (gg * __builtin_amdgcn_rcpf(1.f + fexp(-gg))); }
                    *(u32x2*)(mp + dt * 16) = pack4(ov); }
            }
        }
    }
}
__device__ __forceinline__ void hgrn_a(unsigned char* lds, const Params& p, int jl, bf16_t* proj, bf16_t* mix, float* dbuf, bf16_t* scr, float* useg, float* dseg, int blk, int G, int tid) {
    bf16_t* RAWQ = (bf16_t*)lds;
    bf16_t* RAWZ = (bf16_t*)(lds + 17408);
    bf16_t* QT   = (bf16_t*)(lds + 34816);
    bf16_t* KTL  = (bf16_t*)(lds + 52224);
    bf16_t* VTL  = (bf16_t*)(lds + 69632);
    float*  TOT  = (float*)(lds + 88064);
    bf16_t* KHT  = (bf16_t*)(lds + 90112);
    float*  DLS  = (float*)(lds + 108544);
    const int lane = tid & 63, w = tid >> 6, fr = lane & 15, fq = lane >> 4;
    const int c = tid & 127, tg = tid >> 7;
    for (int u = blk; u < 512; u += G) {
        const bool samp = u >= 256;
        int b, h, chunk0 = 0, nch;
        if (!samp) { b = u >> 6; h = (u >> 2) & 15; chunk0 = b * 128 + (u & 3) * 32; nch = 32; } else { const int su = u - 256; b = su >> 4; h = su & 15; nch = 1; }
        const int nvalid = samp ? 32 : 64;
        const int ch = h * 128 + c;
        float lb = 0.f;
        if (jl == 1) { const float a0 = p.lb[ch], a1 = p.lb[2048 + ch]; lb = 1.f / (1.f + fexp(a0 - a1)); }
        const float lbe = fmaxf(lb, 1e-30f), oml = 1.f - lb;
        f32x4 U[8];
#pragma unroll
        for (int kti = 0; kti < 8; ++kti) U[kti] = (f32x4){0.f, 0.f, 0.f, 0.f};
        float bsum = 0.f;
        const int lrow = tid >> 4, lcc = tid & 15, vkey = tid & 63, vdc = tid >> 6;
        bf16x8 rq0, rq1, rz0, rz1, rv0, rv1;
        const bf16x8 zero8 = {0, 0, 0, 0, 0, 0, 0, 0};
#define HA_LOAD(n) do { const bf16_t* s_ = proj + (size_t)(samp ? MPR + b * 32 : (chunk0 + (n)) * 64) * N4 + h * 128; \
        rq0 = rq1 = rz0 = rz1 = rv0 = rv1 = zero8; \
        if (lrow < nvalid) { rq0 = *(const bf16x8*)(s_ + (size_t)lrow * N4 + lcc * 8); rz0 = *(const bf16x8*)(s_ + (size_t)lrow * N4 + 2048 + lcc * 8); } \
        if (lrow + 32 < nvalid) { rq1 = *(const bf16x8*)(s_ + (size_t)(lrow + 32) * N4 + lcc * 8); rz1 = *(const bf16x8*)(s_ + (size_t)(lrow + 32) * N4 + 2048 + lcc * 8); } \
        if (vkey < nvalid) { rv0 = *(const bf16x8*)(s_ + (size_t)vkey * N4 + 4096 + vdc * 8); rv1 = *(const bf16x8*)(s_ + (size_t)vkey * N4 + 4096 + (vdc + 8) * 8); } } while (0)
        HA_LOAD(0);
        for (int n = 0; n < nch; ++n) {
            int row0, didx, dstride; bf16_t *qd, *kd, *vd;
            if (!samp) { row0 = (chunk0 + n) * 64; didx = chunk0 + n; bf16_t* base = proj + (size_t)row0 * N4 + h * 128; qd = base; kd = base + 2048; vd = base + 4096; dstride = N4; }
            else { row0 = MPR + b * 32; didx = 512 + b; bf16_t* base = scr + (size_t)(u - 256) * 3 * 8192; qd = base; kd = base + 8192; vd = base + 16384; dstride = 128; }
            *(bf16x8*)(RAWQ + lrow * 136 + lcc * 8) = rq0; *(bf16x8*)(RAWQ + (lrow + 32) * 136 + lcc * 8) = rq1;
            *(bf16x8*)(RAWZ + lrow * 136 + lcc * 8) = rz0; *(bf16x8*)(RAWZ + (lrow + 32) * 136 + lcc * 8) = rz1;
#pragma unroll
            for (int e = 0; e < 8; ++e) { VTL[(vdc * 8 + e) * 72 + vkey] = (bf16_t)rv0[e]; VTL[((vdc + 8) * 8 + e) * 72 + vkey] = (bf16_t)rv1[e]; }
            if (n + 1 < nch) HA_LOAD(n + 1);
            __syncthreads();
            float cum[16], kk[16], qs[16]; float run = 0.f;
#pragma unroll
            for (int i = 0; i < 16; ++i) { const int tok = tg * 16 + i; const float q = bf2f((short)RAWQ[tok * 136 + c]), z = bf2f((short)RAWZ[tok * 136 + c]);
                const float e = fexp(-fabsf(z)), r = __builtin_amdgcn_rcpf(1.f + e), er = e * r; const float sp = z >= 0.f ? r : er, sn = z >= 0.f ? er : r;
                float lf = flog(sp + lbe * sn), kv = oml * sn, qq = q * __builtin_amdgcn_rcpf(1.f + fexp(-q));
                if (nvalid < 64) { if (tok >= nvalid) { lf = 0.f; kv = 0.f; qq = 0.f; } }
                run += lf; cum[i] = run; kk[i] = kv; qs[i] = qq; }
            TOT[tg * 128 + c] = run;
            __syncthreads();
            const float t0 = TOT[c], t1 = TOT[128 + c], t2 = TOT[256 + c], t3 = TOT[384 + c];
            const float off = (tg > 0 ? t0 : 0.f) + (tg > 1 ? t1 : 0.f) + (tg > 2 ? t2 : 0.f), bend = (t0 + t1) + (t2 + t3), bref = t0 + t1;
            const float eref = fexp(bref), eend = fexp(bend - bref);
            float kh[16];
#pragma unroll
            for (int i = 0; i < 16; ++i) { const int tok = tg * 16 + i; const float bt = off + cum[i];
                const float e1 = fexp(bt - bref), e2 = fexp(bref - bt);
                const float qt = qs[i] * e1, kt2 = kk[i] * e2, qh = qt * eref; kh[i] = kt2 * eend;
                QT[tok * 136 + c] = f2bf(qt); KTL[tok * 136 + c] = f2bf(kt2); qd[(size_t)tok * dstride + c] = f2bf(qh); }
            { u32x4 w0, w1; w0.x = pk2(kh[0], kh[1]); w0.y = pk2(kh[2], kh[3]); w0.z = pk2(kh[4], kh[5]); w0.w = pk2(kh[6], kh[7]);
              w1.x = pk2(kh[8], kh[9]); w1.y = pk2(kh[10], kh[11]); w1.z = pk2(kh[12], kh[13]); w1.w = pk2(kh[14], kh[15]);
              bf16_t* kp = kd + (size_t)(c >> 1) * dstride + (c & 1) * 64 + tg * 16; *(u32x4*)kp = w0; *(u32x4*)(kp + 8) = w1;
              *(u32x4*)(KHT + c * 72 + tg * 16) = w0; *(u32x4*)(KHT + c * 72 + tg * 16 + 8) = w1; }
            if (tg == 0) { const float dd = fexp(bend); dbuf[(size_t)didx * DM + ch] = dd; DLS[c] = dd; bsum += bend; }
            __syncthreads();
            const int tt = w & 3, vh = w >> 2;
            f32x4 pm[4];
            __builtin_amdgcn_sched_barrier(0);
            { bf16x8 qfr[4];
#pragma unroll
              for (int k4 = 0; k4 < 4; ++k4) qfr[k4] = *(const bf16x8*)(QT + (tt * 16 + fr) * 136 + k4 * 32 + fq * 8);
#pragma unroll
              for (int sh = 0; sh < 2; ++sh) { bf16x8 kfr[2][4];
#pragma unroll
                  for (int s2 = 0; s2 < 2; ++s2)
#pragma unroll
                      for (int k4 = 0; k4 < 4; ++k4) kfr[s2][k4] = *(const bf16x8*)(KTL + ((sh * 2 + s2) * 16 + fr) * 136 + k4 * 32 + fq * 8);
                  __builtin_amdgcn_sched_barrier(0);
#pragma unroll
                  for (int s2 = 0; s2 < 2; ++s2) { const int st = sh * 2 + s2; pm[st] = (f32x4){0.f, 0.f, 0.f, 0.f};
#pragma unroll
                      for (int k4 = 0; k4 < 4; ++k4) pm[st] = MFMA16(kfr[s2][k4], qfr[k4], pm[st]);
#pragma unroll
                      for (int j = 0; j < 4; ++j) { const bool keep = (st < tt) || (st == tt && fq * 4 + j <= fr); pm[st][j] = keep ? pm[st][j] : 0.f; } }
                  __builtin_amdgcn_sched_barrier(0); } }
            bf16x8 pb[2]; pb[0] = pack8(pm[0], pm[1]); pb[1] = pack8(pm[2], pm[3]);
            f32x4 oo[4];
            { bf16x8 vfr[4][2];
#pragma unroll
              for (int vt = 0; vt < 4; ++vt)
#pragma unroll
                  for (int k2 = 0; k2 < 2; ++k2) { const bf16_t* vp = VTL + ((vh * 4 + vt) * 16 + fr) * 72 + k2 * 32 + fq * 4; vfr[vt][k2] = cat8(*(const bf16x4*)vp, *(const bf16x4*)(vp + 16)); }
              __builtin_amdgcn_sched_barrier(0);
#pragma unroll
              for (int vt = 0; vt < 4; ++vt) { oo[vt] = (f32x4){0.f, 0.f, 0.f, 0.f};
#pragma unroll
                  for (int k2 = 0; k2 < 2; ++k2) oo[vt] = MFMA16(vfr[vt][k2], pb[k2], oo[vt]); } }
            { const int tok = tt * 16 + fr;
              if (tok < nvalid) { bf16_t* mp = mix + (size_t)(row0 + tok) * DM + h * 128 + vh * 64 + fq * 4;
#pragma unroll
                  for (int vt = 0; vt < 4; ++vt) *(u32x2*)(mp + vt * 16) = pack4(oo[vt]); } }
#pragma unroll
            for (int i = 0; i < 2; ++i) { const int cidx = tid + 512 * i, v = cidx >> 3, sc = cidx & 7; const bf16x8 x = *(const bf16x8*)(VTL + v * 72 + sc * 8);
                *(bf16x8*)(vd + (size_t)(v >> 1) * dstride + (v & 1) * 64 + sc * 8) = x; }
            __builtin_amdgcn_sched_barrier(0);
            if (!samp) { bf16x8 vb[2];
#pragma unroll
                for (int ks = 0; ks < 2; ++ks) vb[ks] = *(const bf16x8*)(VTL + (w * 16 + fr) * 72 + ks * 32 + fq * 8);
#pragma unroll
                for (int kh2 = 0; kh2 < 2; ++kh2) { bf16x8 kf[4][2]; f32x4 dv[4];
#pragma unroll
                    for (int k3 = 0; k3 < 4; ++k3) { dv[k3] = *(const f32x4*)(DLS + (kh2 * 4 + k3) * 16 + fq * 4);
#pragma unroll
                        for (int ks = 0; ks < 2; ++ks) kf[k3][ks] = *(const bf16x8*)(KHT + ((kh2 * 4 + k3) * 16 + fr) * 72 + ks * 32 + fq * 8); }
                    __builtin_amdgcn_sched_barrier(0);
#pragma unroll
                    for (int k3 = 0; k3 < 4; ++k3) U[kh2 * 4 + k3] = U[kh2 * 4 + k3] * dv[k3];
#pragma unroll
                    for (int ks = 0; ks < 2; ++ks)
#pragma unroll
                        for (int k3 = 0; k3 < 4; ++k3) U[kh2 * 4 + k3] = MFMA16(kf[k3][ks], vb[ks], U[kh2 * 4 + k3]);
                    __builtin_amdgcn_sched_barrier(0); } }
            __syncthreads();
        }
#undef HA_LOAD
        if (!samp) {
            int loff = fq * 512 + w * 16 + fr; asm volatile("" : "+v"(loff));
            float* ud = useg + (size_t)u * 16384 + loff;
#pragma unroll
            for (int kti = 0; kti < 8; ++kti)
#pragma unroll
                for (int j = 0; j < 4; ++j) ud[(kti * 16 + j) * 128] = U[kti][j];
            if (tg == 0) dseg[u * 128 + c] = fexp(bsum);
        }
    }
}

__device__ __forceinline__ void hgrn_b(unsigned char* lds, const Params& p, int jl, const bf16_t* proj, bf16_t* mix, const float* dbuf, const bf16_t* scr, const float* useg, const float* dseg, int blk, int G, int tid) {
    bf16_t* QH = (bf16_t*)lds;
    bf16_t* KT = (bf16_t*)(lds + 34816);
    bf16_t* VT = (bf16_t*)(lds + 71680);
    float* DL = (float*)(lds + 108544);
    float* PART = (float*)(lds + 109568);
    const int lane = tid & 63, w = tid >> 6, fr = lane & 15, fq = lane >> 4;
    for (int u = blk; u < 512; u += G) {
        const bool samp = u >= 256;
        int b, h, seg = 0, sidx = 0;
        if (!samp) { b = u >> 6; h = (u >> 2) & 15; seg = u & 3; } else { sidx = u - 256; b = sidx >> 4; h = sidx & 15; }
        const int nch = samp ? 1 : 32, row0 = samp ? MPR + b * 32 : b * 8192 + seg * 2048, nvalid = samp ? 32 : 64;
        const bf16_t* tq; const bf16_t* tk; const bf16_t* tv; size_t rstride, cstep;
        if (!samp) { const bf16_t* base = proj + (size_t)row0 * N4 + h * 128; tq = base; tk = base + 2048; tv = base + 4096; rstride = N4; cstep = (size_t)64 * N4; }
        else { const bf16_t* base = scr + (size_t)sidx * 3 * 8192; tq = base; tk = base + 8192; tv = base + 16384; rstride = 128; cstep = 0; }
        const float* dsrc = dbuf + (size_t)(samp ? 512 + b : b * 128 + seg * 32) * DM + h * 128;
        const f32x4 ngv = *(const f32x4*)(p.ng + jl * DM + h * 128 + w * 16 + fq * 4);
        bf16x8 rq0, rq1, rk0, rk1, rv0, rv1; f32x4 rd = {0.f, 0.f, 0.f, 0.f};
        const int lrow = tid >> 4, lcc = tid & 15;
#define SEQ_LOAD(n) do { const size_t o0_ = (size_t)(n) * cstep + (size_t)lrow * rstride + lcc * 8, o1_ = o0_ + 32 * rstride; \
        rq0 = *(const bf16x8*)(tq + o0_); rq1 = *(const bf16x8*)(tq + o1_); rk0 = *(const bf16x8*)(tk + o0_); rk1 = *(const bf16x8*)(tk + o1_); \
        rv0 = *(const bf16x8*)(tv + o0_); rv1 = *(const bf16x8*)(tv + o1_); if (tid < 32) rd = *(const f32x4*)(dsrc + (size_t)(n) * DM + tid * 4); } while (0)
#define SEQ_WRITE(bf) do { bf16_t* q_ = QH + (bf) * (64 * 136); bf16_t* k_ = KT + (bf) * (128 * 72); bf16_t* v_ = VT + (bf) * (128 * 72); \
        *(bf16x8*)(q_ + lrow * 136 + lcc * 8) = rq0; *(bf16x8*)(q_ + (lrow + 32) * 136 + lcc * 8) = rq1; \
        const int kk0_ = 2 * lrow + (lcc >> 3), so_ = (lcc & 7) * 8; \
        *(bf16x8*)(k_ + kk0_ * 72 + so_) = rk0; *(bf16x8*)(k_ + (kk0_ + 64) * 72 + so_) = rk1; *(bf16x8*)(v_ + kk0_ * 72 + so_) = rv0; *(bf16x8*)(v_ + (kk0_ + 64) * 72 + so_) = rv1; \
        if (tid < 32) *(f32x4*)(DL + (bf) * 128 + tid * 4) = rd; } while (0)
        SEQ_LOAD(0);
        f32x4 S[8];
#pragma unroll
        for (int kti = 0; kti < 8; ++kti)
#pragma unroll
            for (int j = 0; j < 4; ++j) S[kti][j] = samp ? p.st_in[(size_t)((jl * 16 + b) * 16 + h) * 16384 + (kti * 16 + fq * 4 + j) * 128 + w * 16 + fr] : 0.f;
        for (int sj = 0; sj < seg; ++sj) { const float* Uj = useg + (size_t)(u - seg + sj) * 16384 + w * 16 + fr; const float* Dj = dseg + (u - seg + sj) * 128;
#pragma unroll
            for (int kti = 0; kti < 8; ++kti) { const f32x4 dv = *(const f32x4*)(Dj + kti * 16 + fq * 4);
#pragma unroll
                for (int j = 0; j < 4; ++j) S[kti][j] = S[kti][j] * dv[j] + Uj[(kti * 16 + fq * 4 + j) * 128]; } }
        SEQ_WRITE(0);
        __syncthreads();
        for (int n = 0; n < nch; ++n) {
            const int buf = n & 1;
            if (n + 1 < nch) SEQ_LOAD(n + 1);
            u32x2 oin[4], gin[4];
#pragma unroll
            for (int tt = 0; tt < 4; ++tt) { const int tok = tt * 16 + fr; oin[tt] = (u32x2){0u, 0u}; gin[tt] = (u32x2){0u, 0u};
                if (tok < nvalid) { const size_t row = (size_t)row0 + (size_t)n * 64 + tok;
                    oin[tt] = *(const u32x2*)(mix + row * DM + h * 128 + w * 16 + fq * 4); gin[tt] = *(const u32x2*)(proj + row * N4 + 6144 + h * 128 + w * 16 + fq * 4); } }
            const bf16_t* qh = QH + buf * (64 * 136); const bf16_t* kt = KT + buf * (128 * 72); const bf16_t* vt = VT + buf * (128 * 72); const float* dl = DL + buf * 128;
            f32x4 oT[4];
            { bf16x8 sa[4];
#pragma unroll
              for (int k2 = 0; k2 < 4; ++k2) sa[k2] = pack8(S[2 * k2], S[2 * k2 + 1]);
#pragma unroll
              for (int th = 0; th < 2; ++th) { bf16x8 qfr[2][4];
#pragma unroll
                  for (int t2 = 0; t2 < 2; ++t2)
#pragma unroll
                      for (int k2 = 0; k2 < 4; ++k2) { const bf16_t* qp = qh + ((th * 2 + t2) * 16 + fr) * 136 + k2 * 32 + fq * 4; qfr[t2][k2] = cat8(*(const bf16x4*)qp, *(const bf16x4*)(qp + 16)); }
                  __builtin_amdgcn_sched_barrier(0);
#pragma unroll
                  for (int t2 = 0; t2 < 2; ++t2) oT[th * 2 + t2] = (f32x4){0.f, 0.f, 0.f, 0.f};
#pragma unroll
                  for (int k2 = 0; k2 < 4; ++k2)
#pragma unroll
                      for (int t2 = 0; t2 < 2; ++t2) oT[th * 2 + t2] = MFMA16(sa[k2], qfr[t2][k2], oT[th * 2 + t2]);
                  __builtin_amdgcn_sched_barrier(0); } }
            { bf16x8 vb[2];
#pragma unroll
              for (int ks = 0; ks < 2; ++ks) vb[ks] = *(const bf16x8*)(vt + (w * 16 + fr) * 72 + ks * 32 + fq * 8);
#pragma unroll
              for (int kh2 = 0; kh2 < 2; ++kh2) { bf16x8 kf[4][2]; f32x4 dv[4];
#pragma unroll
                  for (int k3 = 0; k3 < 4; ++k3) { dv[k3] = *(const f32x4*)(dl + (kh2 * 4 + k3) * 16 + fq * 4);
#pragma unroll
                      for (int ks = 0; ks < 2; ++ks) kf[k3][ks] = *(const bf16x8*)(kt + ((kh2 * 4 + k3) * 16 + fr) * 72 + ks * 32 + fq * 8); }
                  __builtin_amdgcn_sched_barrier(0);
#pragma unroll
                  for (int k3 = 0; k3 < 4; ++k3) S[kh2 * 4 + k3] = S[kh2 * 4 + k3] * dv[k3];
#pragma unroll
                  for (int ks = 0; ks < 2; ++ks)
#pragma unroll
                      for (int k3 = 0; k3 < 4; ++k3) S[kh2 * 4 + k3] = MFMA16(kf[k3][ks], vb[ks], S[kh2 * 4 + k3]);
                  __builtin_amdgcn_sched_barrier(0); } }
#pragma unroll
            for (int tt = 0; tt < 4; ++tt) { float ss = 0.f;
#pragma unroll
                for (int j = 0; j < 4; ++j) { const unsigned wv = oin[tt][j >> 1]; const float oi = __uint_as_float((j & 1) ? (wv & 0xffff0000u) : (wv << 16)); const float ov = oT[tt][j] + oi; oT[tt][j] = ov; ss += ov * ov; }
                ss += __shfl_xor(ss, 16); ss += __shfl_xor(ss, 32);
                if (fq == 0) PART[(tt * 16 + fr) * 8 + w] = ss; }
            __syncthreads();
#pragma unroll
            for (int tt = 0; tt < 4; ++tt) { const int tok = tt * 16 + fr; const float* pp = PART + tok * 8; const f32x4 pa = *(const f32x4*)pp, pb2 = *(const f32x4*)(pp + 4);
                const float tot = ((pa[0] + pa[1]) + (pa[2] + pa[3])) + ((pb2[0] + pb2[1]) + (pb2[2] + pb2[3]));
                const float rstd = rsqrtf(tot * (1.f / 128.f) + 1e-6f); f32x4 ov;
#pragma unroll
                for (int j = 0; j < 4; ++j) { const unsigned wv = gin[tt][j >> 1]; const float gg = __uint_as_float((j & 1) ? (wv & 0xffff0000u) : (wv << 16)); ov[j] = oT[tt][j] * rstd * ngv[j] * (gg * __builtin_amdgcn_rcpf(1.f + fexp(-gg))); }
                if (tok < nvalid) *(u32x2*)(mix + ((size_t)row0 + (size_t)n * 64 + tok) * DM + h * 128 + w * 16 + fq * 4) = pack4(ov); }
            if (n + 1 < nch) SEQ_WRITE(buf ^ 1);
            __syncthreads();
        }
#undef SEQ_LOAD
#undef SEQ_WRITE
        if (samp || seg == 3) {
            float* sdst = p.out + (samp ? O_STS + (size_t)((jl * 16 + b) * 16 + h) * 16384 : O_STP + (size_t)((jl * 4 + b) * 16 + h) * 16384);
            int loff = fq * 512 + w * 16 + fr; asm volatile("" : "+v"(loff));
            sdst += loff;
#pragma unroll
            for (int kti = 0; kti < 8; ++kti)
#pragma unroll
                for (int j = 0; j < 4; ++j) sdst[(kti * 16 + j) * 128] = S[kti][j];
        }
    }
}
__device__ __forceinline__ void grid_bar(unsigned* bar, unsigned target, int tid) {
    asm volatile("s_waitcnt vmcnt(0)" ::: "memory");
    __syncthreads();
    if (tid == 0) {
        __builtin_amdgcn_fence(__ATOMIC_RELEASE, "agent");
        asm volatile("s_waitcnt vmcnt(0)" ::: "memory");
        __hip_atomic_fetch_add(bar, 1u, __ATOMIC_RELAXED, __HIP_MEMORY_SCOPE_AGENT);
        while (__hip_atomic_load(bar, __ATOMIC_RELAXED, __HIP_MEMORY_SCOPE_AGENT) < target) __builtin_amdgcn_s_sleep(1);
        __builtin_amdgcn_fence(__ATOMIC_ACQUIRE, "agent");
        asm volatile("s_waitcnt vmcnt(0)" ::: "memory");
    }
    __syncthreads();
}

typedef __attribute__((address_space(1))) unsigned gu32;
#define XB_TMO      128
#define XB_XCNT(j)  (256  + 64 * (j))
#define XB_XSUB(j)  (1280 + 64 * (j))
#define XB_XGEN(j)  (2304 + 64 * (j))
#define XB_TOP      3328
#define XB_TOPGEN   3392
#define XCD_BAR_WORDS 3456
#define XB_SPIN_CAP (1u << 18)

__device__ __forceinline__ unsigned xb_ld(unsigned* p)              { return __hip_atomic_load(p, __ATOMIC_RELAXED, __HIP_MEMORY_SCOPE_AGENT); }
__device__ __forceinline__ unsigned xb_add(unsigned* p, unsigned v) { return __hip_atomic_fetch_add(p, v, __ATOMIC_RELAXED, __HIP_MEMORY_SCOPE_AGENT); }
__device__ __forceinline__ unsigned xb_xcc_id() { return (unsigned)__builtin_amdgcn_s_getreg((3 << 11) | 20) & 0xFu; }
#define XB_SPIN(cond, bar) do { unsigned _sp = 0; while (cond) { __builtin_amdgcn_s_sleep(1); \
    if ((++_sp & 255u) == 0u) { if (xb_ld(&(bar)[XB_TMO])) break; if (_sp > XB_SPIN_CAP) { atomicAdd(&(bar)[XB_TMO], 1u); break; } } } } while (0)

struct XcdBarrier {
    unsigned* bar; unsigned x;
    volatile LAS unsigned* st;
};

__device__ __forceinline__ XcdBarrier xcd_barrier_post(unsigned* bar, volatile LAS unsigned* st) {
    XcdBarrier b; b.bar = bar; b.x = xb_xcc_id(); b.st = st;
    if (threadIdx.x == 0) (void)xb_add(&bar[XB_XCNT(b.x)], 1u);
    return b;
}
__device__ __forceinline__ void xcd_barrier_complete(unsigned* bar, unsigned x, unsigned& nloc, unsigned& nx) {
    const unsigned G = gridDim.x * gridDim.y * gridDim.z;
    unsigned sum, cnt, mine, sp = 0u;
    for (;;) {
        sum = 0u; cnt = 0u; mine = 0u;
#pragma unroll
        for (unsigned j = 0; j < 16; ++j) { const unsigned c = xb_ld(&bar[XB_XCNT(j)]); sum += c; cnt += (c > 0u) ? 1u : 0u; mine = (j == x) ? c : mine; }
        if (sum == G) break;
        __builtin_amdgcn_s_sleep(1);
        if ((++sp & 255u) == 0u) { if (xb_ld(&bar[XB_TMO])) break; if (sp > XB_SPIN_CAP) { atomicAdd(&bar[XB_TMO], 1u); break; } }
    }
    nloc = mine > 0u ? mine : 1u; nx = cnt > 0u ? cnt : 1u;
}

__device__ __forceinline__ void xcd_barrier(const XcdBarrier& b) {
    asm volatile("s_waitcnt vmcnt(0)" ::: "memory");
    __syncthreads();
    if (threadIdx.x == 0) {
        unsigned* bar = b.bar;
        __builtin_amdgcn_s_waitcnt(0);
        unsigned nloc = b.st[0], nx = b.st[1];
        if (nloc == 0u) { xcd_barrier_complete(bar, b.x, nloc, nx); b.st[0] = nloc; b.st[1] = nx; }
        const unsigned old = xb_add(&bar[XB_XSUB(b.x)], 1u);
        const unsigned gen = old / nloc;
        if (old + 1u == (gen + 1u) * nloc) {
            __builtin_amdgcn_fence(__ATOMIC_RELEASE, "agent");
            asm volatile("s_waitcnt vmcnt(0)" ::: "memory");
            const unsigned og = xb_add(&bar[XB_TOP], 1u);
            const unsigned tg = og / nx;
            if (og + 1u == (tg + 1u) * nx) xb_add(&bar[XB_TOPGEN], 1u);
            else XB_SPIN(xb_ld(&bar[XB_TOPGEN]) == tg, bar);
            __builtin_amdgcn_fence(__ATOMIC_ACQUIRE, "agent");
            xb_add(&bar[XB_XGEN(b.x)], 1u);
            asm volatile("s_waitcnt vmcnt(0)" ::: "memory");
        } else {
            XB_SPIN(xb_ld(&bar[XB_XGEN(b.x)]) == gen, bar);
            __builtin_amdgcn_fence(__ATOMIC_ACQUIRE, "agent");
            asm volatile("s_waitcnt vmcnt(0)" ::: "memory");
        }
    }
    __syncthreads();
}

__global__ void __launch_bounds__(512, 2) fwd_kernel(Params p) {
    extern __shared__ __attribute__((aligned(16))) unsigned char lds[];
    const int wave_s = __builtin_amdgcn_readfirstlane((int)(threadIdx.x >> 6));
    const int blk0 = blockIdx.x, G0 = gridDim.x;
    bf16_t* win_t = (bf16_t*)(p.ws + WS_WIN); bf16_t* wout_t = (bf16_t*)(p.ws + WS_WOUT); bf16_t* hb = (bf16_t*)(p.ws + WS_HB);
    bf16_t* proj = (bf16_t*)(p.ws + WS_PROJ); bf16_t* mix = (bf16_t*)(p.ws + WS_MIX); float* dbuf = (float*)(p.ws + WS_DBUF); bf16_t* scr = (bf16_t*)(p.ws + WS_SCR);
    float* useg = (float*)(p.ws + WS_USEG); float* dseg = (float*)(p.ws + WS_DSEG); unsigned* bar = (unsigned*)(p.ws + WS_CTL);
    float* hf = p.out + O_YP;
    volatile LAS unsigned* bst = (volatile LAS unsigned*)((LAS unsigned char*)lds + 133120);
    if (threadIdx.x < 2) bst[threadIdx.x] = 0u;
    __syncthreads();
    const XcdBarrier xbar = xcd_barrier_post(bar, bst);
#define LAUNDER() int tid, blk = blk0, G = G0; asm volatile("v_mbcnt_lo_u32_b32 %0, -1, 0\n\tv_mbcnt_hi_u32_b32 %0, -1, %0" : "=v"(tid)); tid += wave_s * 64; asm volatile("" : "+v"(tid), "+s"(blk), "+s"(G))
#define GRID_BAR() do { xcd_barrier(xbar); } while (0)
    { LAUNDER(); p0_phase(lds, p, win_t, wout_t, hb, blk, G, tid); }
    cg::this_grid().sync();
    for (int layer = 0; layer < 4; ++layer) {
        const int jl = layer >> 1;
        { LAUNDER(); pg8::Gemm g{hb, win_t + (size_t)layer * N4 * DM, MPR, N4, DM}; pg8::StaticOrder S; S.init(MPR, N4, G, blk); pg8::EpiProjT<true> E{proj, N4};
          pg8::gemm_phase<pg8::EpiProjT<true>, pg8::StaticOrder, false, true>((LAS unsigned char*)lds, g, S, E, tid);
          pg8::mini_gemm((LAS unsigned char*)lds, hb + (size_t)MPR * DM, win_t + (size_t)layer * N4 * DM, proj + (size_t)MPR * N4, N4, N4, blk, G, tid); }
        GRID_BAR();
        if ((layer & 1) == 0) { { LAUNDER(); hgrn_a(lds, p, jl, proj, mix, dbuf, scr, useg, dseg, blk, G, tid); } GRID_BAR(); { LAUNDER(); hgrn_b(lds, p, jl, proj, mix, dbuf, scr, useg, dseg, blk, G, tid); } }
        else { LAUNDER(); attn_phase(lds, p, jl, proj, mix, blk, G, tid); }
        GRID_BAR();
        { LAUNDER(); pg8::Gemm g{mix, wout_t + (size_t)layer * DM * DM, MPR, DM, DM}; pg8::StaticOrder S; S.init(MPR, DM, G, blk); pg8::EpiProjT<false> E{proj, DM};
          pg8::gemm_phase<pg8::EpiProjT<false>, pg8::StaticOrder, false, true>((LAS unsigned char*)lds, g, S, E, tid);
          pg8::mini_gemm((LAS unsigned char*)lds, mix + (size_t)MPR * DM, wout_t + (size_t)layer * DM * DM, proj + (size_t)MPR * DM, DM, DM, blk, G, tid); }
        GRID_BAR();
        { LAUNDER(); ln_phase(p, layer, hf, hb, proj, p.ln_g + layer * DM, p.ln_b + layer * DM, blk, G, tid); }
        if (layer < 3) GRID_BAR();
    }
}

extern "C" void kernel_launch(void* const* d_in, const int* in_sizes, int n_in, void* d_out, int out_size, void* d_ws, size_t ws_size, hipStream_t stream) {
    static int grid = 0;
    if (grid == 0) {
        if (n_in != 12 || ws_size < WS_END || out_size != 99614720) { fprintf(stderr, "kernel_launch: unexpected shapes (n_in %d, out %d, ws %zu)\n", n_in, out_size, ws_size); grid = -1; return; }
        int dev = 0, cus = 0, per_cu = 0;
        (void)hipGetDevice(&dev); (void)hipDeviceGetAttribute(&cus, hipDeviceAttributeMultiprocessorCount, dev);
        if (hipFuncSetAttribute((const void*)fwd_kernel, hipFuncAttributeMaxDynamicSharedMemorySize, LDS_BYTES) != hipSuccess) fprintf(stderr, "kernel_launch: hipFuncSetAttribute failed\n");
        if (hipOccupancyMaxActiveBlocksPerMultiprocessor(&per_cu, (const void*)fwd_kernel, 512, LDS_BYTES) != hipSuccess || per_cu < 1) { fprintf(stderr, "kernel_launch: occupancy query gave %d\n", per_cu); per_cu = 1; }
        (void)hipGetLastError();
        if (cus <= 0) cus = 256;
        grid = cus * per_cu;
    }
    if (grid < 0) return;
    (void)hipMemsetAsync((unsigned char*)d_ws + WS_CTL, 0, 16384, stream);
    Params p{};
    p.xp = (const float*)d_in[0]; p.xs = (const float*)d_in[1]; p.st_in = (const float*)d_in[2]; p.ck_in = (const float*)d_in[3]; p.cv_in = (const float*)d_in[4];
    p.w_in = (const float*)d_in[5]; p.w_out = (const float*)d_in[6]; p.ln_g = (const float*)d_in[7]; p.ln_b = (const float*)d_in[8]; p.lb = (const float*)d_in[9];
    p.ng = (const float*)d_in[10]; p.rb = (const float*)d_in[11]; p.out = (float*)d_out; p.ws = (unsigned char*)d_ws;
    void* args[] = {&p};
    hipError_t e = hipLaunchCooperativeKernel((const void*)fwd_kernel, dim3(grid), dim3(512), args, LDS_BYTES, stream);
    if (e != hipSuccess) fprintf(stderr, "kernel_launch: cooperative launch failed: %s (grid %d)\n", hipGetErrorString(e), grid);
}
```
